# Optimizing an MI355X kernel written in HIP

```python
import jax, jax.numpy as jnp
from jax import lax
import numpy as np

D_MODEL = 1024
BATCH = 16
SEQ = 2048
DEPTH = 2
DEC_BATCH = 128
DEC_SEQ = 8
PAST_LEN = 16384
PAGE_SIZE = 128

HEAD_DIM = 64
N_HEADS = D_MODEL // 128
KV_HEADS = N_HEADS // 4
Q_W = N_HEADS * HEAD_DIM
KV_W = KV_HEADS * HEAD_DIM
WINDOW = 128
CHUNK = 128
GM_GROUPS = 4
GM_W = D_MODEL // 2
GM_GW = GM_W // GM_GROUPS
SC_W = D_MODEL // 2
CONV_W = 3
D_FF = 2816
N_BRANCH = 3
IN_COLS = Q_W + 2 * KV_W + 2 * GM_W + 3 * SC_W
ALPHA = (2.0 * DEPTH) ** 0.25
BETA = (8.0 * DEPTH) ** -0.25
LN_EPS = 1e-5

kernel_name = "hybrid_swa_gmlp_shortconv_convffn_deepnorm_step"


def layer_norm(x, g, b):
    xf = x.astype(jnp.float32)
    mu = xf.mean(-1, keepdims=True)
    var = jnp.square(xf - mu).mean(-1, keepdims=True)
    return ((xf - mu) * lax.rsqrt(var + LN_EPS) * g.astype(jnp.float32) + b.astype(jnp.float32)).astype(x.dtype)


def causal_dwconv(x, w, past):
    T = x.shape[1]
    xp = jnp.concatenate([past.astype(x.dtype), x], axis=1)
    y = w[0] * xp[:, 0:T]
    for k in range(1, CONV_W):
        y = y + w[k] * xp[:, k:k + T]
    return y, xp[:, -(CONV_W - 1):]


def alibi_slopes():
    return 2.0 ** (-8.0 * jnp.arange(1, N_HEADS + 1, dtype=jnp.float32) / N_HEADS)


def swa_attend(q, kk, vv, key_valid, sinks):
    B, N, T = q.shape[:3]
    S = kk.shape[2]
    G = N_HEADS // KV_HEADS
    qg = q.reshape(B, N, T, KV_HEADS, G, HEAD_DIM)
    s = jnp.einsum('bntkgd,bnskd->bnkgts', qg, kk).astype(jnp.float32) * (HEAD_DIM ** -0.5)
    dist_i = jnp.arange(T)[:, None] + WINDOW - jnp.arange(S)[None, :]
    slopes = alibi_slopes().reshape(KV_HEADS, G)
    s = s - slopes[:, :, None, None] * dist_i.astype(jnp.float32)
    allowed = (dist_i >= 0) & (dist_i <= WINDOW)
    mask = allowed[None, :, :] & key_valid[:, None, :]
    s = jnp.where(mask[None, :, None, None], s, -jnp.inf)
    sink = sinks.astype(jnp.float32).reshape(KV_HEADS, G)[:, :, None, None]
    m = jnp.maximum(s.max(-1, keepdims=True), sink)
    p = jnp.exp(s - m)
    denom = p.sum(-1, keepdims=True) + jnp.exp(sink - m)
    o = jnp.einsum('bnkgts,bnskd->bntkgd', (p / denom).astype(vv.dtype), vv)
    return o.reshape(B, N * T, Q_W)


def token_mixer(x, prompt, k_buf, v_buf, conv_past, w_in, w_gate, b_gate, gmlp_ln_g, gmlp_ln_b,
                gmlp_ws, gmlp_bs, mixconv_w, sinks, p_attn, p_gmlp, p_conv, w_o):
    B, T, _ = x.shape
    h = x @ w_in
    offs = np.cumsum([Q_W, KV_W, KV_W, GM_W, GM_W, SC_W, SC_W]).tolist()
    q, k, v, gu, gv, sb, sc, sh = jnp.split(h, offs, axis=-1)

    q = q.reshape(B, T, N_HEADS, HEAD_DIM)
    k = k.reshape(B, T, KV_HEADS, HEAD_DIM)
    v = v.reshape(B, T, KV_HEADS, HEAD_DIM)
    if prompt:
        N = T // WINDOW
        qb = q.reshape(B, N, WINDOW, N_HEADS, HEAD_DIM)
        kb = k.reshape(B, N, WINDOW, KV_HEADS, HEAD_DIM)
        vb = v.reshape(B, N, WINDOW, KV_HEADS, HEAD_DIM)
        kk = jnp.concatenate([jnp.concatenate([jnp.zeros_like(kb[:, :1]), kb[:, :-1]], axis=1), kb], axis=2)
        vv = jnp.concatenate([jnp.concatenate([jnp.zeros_like(vb[:, :1]), vb[:, :-1]], axis=1), vb], axis=2)
        key_valid = (jnp.arange(N)[:, None] * WINDOW + jnp.arange(2 * WINDOW)[None, :] - WINDOW) >= 0
        attn = swa_attend(qb, kk, vv, key_valid, sinks)
        new_k, new_v = k[:, -WINDOW:], v[:, -WINDOW:]
    else:
        kk = jnp.concatenate([k_buf.astype(k.dtype), k], axis=1)
        vv = jnp.concatenate([v_buf.astype(v.dtype), v], axis=1)
        key_valid = jnp.ones((1, WINDOW + T), dtype=bool)
        attn = swa_attend(q[:, None], kk[:, None], vv[:, None], key_valid, sinks)
        new_k, new_v = kk[:, -WINDOW:], vv[:, -WINDOW:]

    gv = layer_norm(gv, gmlp_ln_g, gmlp_ln_b)
    Tc = CHUNK if prompt else T
    N = T // Tc
    vr = gv.reshape(B, N, Tc, GM_GROUPS, GM_GW)
    ws = jnp.tril(gmlp_ws[:, :Tc, :Tc])
    sv = jnp.einsum('gts,bnsgc->bntgc', ws, vr) + gmlp_bs[:, :Tc].T[None, None, :, :, None]
    gm = gu * sv.reshape(B, T, GM_W)

    past = jnp.zeros((B, CONV_W - 1, SC_W), x.dtype) if prompt else conv_past
    cz, new_conv = causal_dwconv(sc * sh, mixconv_w, past)
    scv = sb * cz

    gates = jax.nn.sigmoid(x @ w_gate + b_gate).reshape(B, T, N_BRANCH, D_MODEL)
    merged = (gates[:, :, 0] * (attn @ p_attn) + gates[:, :, 1] * (gm @ p_gmlp)
              + gates[:, :, 2] * (scv @ p_conv))
    return merged @ w_o, new_k, new_v, new_conv, gv


def conv_ffn(x, prompt, past, w_up, conv_w, conv_b, w_down):
    B = x.shape[0]
    up = x @ w_up
    if prompt:
        past = jnp.zeros((B, CONV_W - 1, 2 * D_FF), x.dtype)
    c, new_past = causal_dwconv(up, conv_w, past)
    c = c + conv_b
    a, g = jnp.split(c, [D_FF], axis=-1)
    return (jax.nn.silu(g) * a) @ w_down, new_past


def setup_inputs(seed: int = 0) -> dict:
    key = jax.random.key(seed)
    ks = iter(jax.random.split(key, 32))

    def nrm(shape, scale):
        return jax.random.normal(next(ks), shape, jnp.float32) * scale

    L, D = DEPTH, D_MODEL
    return {
        "x_prompt": nrm((BATCH, SEQ, D), 1.0),
        "x_sample": nrm((DEC_BATCH, DEC_SEQ, D), 1.0),
        "cache_k_win": nrm((L, DEC_BATCH, WINDOW, KV_HEADS, HEAD_DIM), 1.0),
        "cache_v_win": nrm((L, DEC_BATCH, WINDOW, KV_HEADS, HEAD_DIM), 1.0),
        "state_mixconv": nrm((L, DEC_BATCH, CONV_W - 1, SC_W), 1.0),
        "state_ffnconv": nrm((L, DEC_BATCH, CONV_W - 1, 2 * D_FF), 1.0),
        "w_in": nrm((L, D, IN_COLS), D ** -0.5),
        "w_gate": nrm((L, D, N_BRANCH * D), D ** -0.5),
        "b_gate": nrm((L, N_BRANCH * D), 0.1),
        "gmlp_ln_g": 1.0 + nrm((L, GM_W), 0.1),
        "gmlp_ln_b": nrm((L, GM_W), 0.1),
        "gmlp_ws": nrm((L, GM_GROUPS, CHUNK, CHUNK), CHUNK ** -0.5),
        "gmlp_bs": 1.0 + nrm((L, GM_GROUPS, CHUNK), 0.1),
        "mixconv_w": nrm((L, CONV_W, SC_W), CONV_W ** -0.5),
        "attn_sinks": nrm((L, N_HEADS), 0.5),
        "p_attn": nrm((L, Q_W, D), BETA * Q_W ** -0.5),
        "p_gmlp": nrm((L, GM_W, D), BETA * GM_W ** -0.5),
        "p_conv": nrm((L, SC_W, D), BETA * SC_W ** -0.5),
        "w_o": nrm((L, D, D), BETA * D ** -0.5),
        "ln1_g": 1.0 + nrm((L, D), 0.1),
        "ln1_b": nrm((L, D), 0.1),
        "w_up": nrm((L, D, 2 * D_FF), D ** -0.5),
        "ffn_conv_w": nrm((L, CONV_W, 2 * D_FF), CONV_W ** -0.5),
        "ffn_conv_b": nrm((L, 2 * D_FF), 0.02),
        "w_down": nrm((L, D_FF, D), BETA * D_FF ** -0.5),
        "ln2_g": 1.0 + nrm((L, D), 0.1),
        "ln2_b": nrm((L, D), 0.1),
    }


def reference(x_prompt, x_sample, cache_k_win, cache_v_win, state_mixconv, state_ffnconv,
              w_in, w_gate, b_gate, gmlp_ln_g, gmlp_ln_b, gmlp_ws, gmlp_bs, mixconv_w, attn_sinks,
              p_attn, p_gmlp, p_conv, w_o, ln1_g, ln1_b, w_up, ffn_conv_w, ffn_conv_b, w_down,
              ln2_g, ln2_b):
    xp, xs = x_prompt, x_sample
    kp, vp, mcp, fcp = [], [], [], []
    ksm, vsm, mcs, fcs, gvs = [], [], [], [], []
    for l in range(DEPTH):
        mix_w = (w_in[l], w_gate[l], b_gate[l], gmlp_ln_g[l], gmlp_ln_b[l], gmlp_ws[l], gmlp_bs[l],
                 mixconv_w[l], attn_sinks[l], p_attn[l], p_gmlp[l], p_conv[l], w_o[l])
        m, nk, nv, nc, _ = token_mixer(xp, True, None, None, None, *mix_w)
        xp = layer_norm(ALPHA * xp + m, ln1_g[l], ln1_b[l])
        f, nf = conv_ffn(xp, True, None, w_up[l], ffn_conv_w[l], ffn_conv_b[l], w_down[l])
        xp = layer_norm(ALPHA * xp + f, ln2_g[l], ln2_b[l])
        kp.append(nk); vp.append(nv); mcp.append(nc); fcp.append(nf)
        m, nk, nv, nc, gv = token_mixer(xs, False, cache_k_win[l], cache_v_win[l], state_mixconv[l], *mix_w)
        xs = layer_norm(ALPHA * xs + m, ln1_g[l], ln1_b[l])
        f, nf = conv_ffn(xs, False, state_ffnconv[l], w_up[l], ffn_conv_w[l], ffn_conv_b[l], w_down[l])
        xs = layer_norm(ALPHA * xs + f, ln2_g[l], ln2_b[l])
        ksm.append(nk); vsm.append(nv); mcs.append(nc); fcs.append(nf); gvs.append(gv)
    return (xp, xs,
            jnp.stack(kp), jnp.stack(vp), jnp.stack(mcp), jnp.stack(fcp),
            jnp.stack(ksm), jnp.stack(vsm), jnp.stack(mcs), jnp.stack(fcs), jnp.stack(gvs))
```

```cpp
#include <hip/hip_runtime.h>
#include <hip/hip_cooperative_groups.h>
#include <cstdio>
#include <cstdint>
namespace cg = cooperative_groups;

#define LAS __attribute__((address_space(3)))
#define DI __device__ __forceinline__
typedef unsigned short bf16_t;
typedef short bf16x8 __attribute__((ext_vector_type(8)));
typedef float f32x4 __attribute__((ext_vector_type(4)));
typedef float f32x16 __attribute__((ext_vector_type(16)));
typedef unsigned u32x4 __attribute__((ext_vector_type(4)));
typedef unsigned u32x2 __attribute__((ext_vector_type(2)));

constexpr int MP = 32768, MS = 1024, MT = MP + MS, DM = 1024, NIN = 3328, NGATE = 3072, DFF = 2816, NUP = 5632;
constexpr int SEQ = 2048, NB = 16, DB = 128, DS = 8;
constexpr int QO = 0, KO = 512, VO = 640, GUO = 768, GVO = 1280, SBO = 1792, SCO = 2304, SHO = 2816, MGO = 2304;
constexpr int LDH = 3328;
constexpr float ALPHA = 1.41421356237309515f;
constexpr float LN_EPS = 1e-5f;
constexpr size_t W_IN = 0, W_G = W_IN + (size_t)NIN * DM, W_PA = W_G + (size_t)NGATE * DM, W_PG = W_PA + 512 * 1024, W_PC = W_PG + 512 * 1024,
                 W_O = W_PC + 512 * 1024, W_UP = W_O + 1024 * 1024, W_DN = W_UP + (size_t)NUP * DM, W_LAYER = W_DN + (size_t)DM * DFF;
constexpr size_t MiB = 1u << 20;
constexpr size_t WS_WT = 1 * MiB, WS_XB = 69 * MiB, WS_H = 135 * MiB, WS_GS = 350 * MiB, WS_HALO = 478 * MiB, WS_XBUF = 490 * MiB, WS_PART = 496 * MiB, WS_END = 500 * MiB;
constexpr size_t WS_CNT = 16384, CTL_ZERO_BYTES = 262144;
constexpr size_t XBUF_INST = (size_t)132 * 256 * 4 * 8;
constexpr size_t WS_PFLAG = WS_CNT + 4 * 132 * 256;
static_assert(WS_PFLAG + 6 * 16 * 256 <= CTL_ZERO_BYTES && WS_PART + (size_t)16 * 512 * 512 <= WS_END, "ws map 4");
static_assert(WS_CNT + 4 * 132 * 256 <= CTL_ZERO_BYTES && WS_XBUF + 4 * XBUF_INST <= WS_END, "ws map 3");
constexpr int XL_OFF = 131072;
static_assert(WS_WT + 2 * W_LAYER * 2 <= WS_XB && WS_XB + (size_t)MT * DM * 2 <= WS_H && WS_H + (size_t)MT * LDH * 2 <= WS_GS, "ws map");
static_assert(WS_GS + (size_t)MT * NGATE <= WS_HALO && WS_HALO + (size_t)132 * 4 * NUP * 4 <= WS_END, "ws map 2");
constexpr size_t O_Y = 0, O_KP = (size_t)MT * DM, O_VP = O_KP + 524288, O_MCP = O_VP + 524288, O_FCP = O_MCP + 32768, O_KS = O_FCP + 360448,
                 O_VS = O_KS + 4194304, O_MCS = O_VS + 4194304, O_FCS = O_MCS + 262144, O_GVS = O_FCS + 2883584, O_END = O_GVS + 1048576;
constexpr int LDS_BYTES = 147456;
constexpr int HL_OFF = 131072;

typedef float f32x2_t __attribute__((ext_vector_type(2)));
typedef __bf16 bf16x2_t __attribute__((ext_vector_type(2)));
DI unsigned cvt_pk_bf16(float lo, float hi) { const f32x2_t v = {lo, hi}; return __builtin_bit_cast(unsigned, __builtin_convertvector(v, bf16x2_t)); }
DI float bf_lo(unsigned u) { return __uint_as_float(u << 16); }
DI float bf_hi(unsigned u) { return __uint_as_float(u & 0xffff0000u); }
DI float bf2f(bf16_t h) { return __uint_as_float((unsigned)h << 16); }
DI bf16_t f2bf(float f) { return (bf16_t)(cvt_pk_bf16(f, 0.f) & 0xffffu); }
DI float fast_exp(float x) { return __builtin_amdgcn_exp2f(x * 1.44269504089f); }
DI float sigmoidf(float x) { x = fminf(fmaxf(x, -30.f), 30.f); return __builtin_amdgcn_rcpf(1.f + fast_exp(-x)); }
DI float wave_sum(float v) {
#pragma unroll
    for (int o = 1; o < 64; o <<= 1) v += __shfl_xor(v, o);
    return v;
}
DI float wave_max(float v) {
#pragma unroll
    for (int o = 1; o < 64; o <<= 1) v = fmaxf(v, __shfl_xor(v, o));
    return v;
}
template <int CTRL> DI float dppz(float src) {
    return __builtin_bit_cast(float, __builtin_amdgcn_update_dpp(0, __builtin_bit_cast(int, src), CTRL, 0xf, 0xf, true));
}
template <int CTRL> DI f32x4 dppz4(f32x4 s) { f32x4 r; r.x = dppz<CTRL>(s.x); r.y = dppz<CTRL>(s.y); r.z = dppz<CTRL>(s.z); r.w = dppz<CTRL>(s.w); return r; }
template <int CTRL> DI float dppo(float old, float src) {
    return __builtin_bit_cast(float, __builtin_amdgcn_update_dpp(__builtin_bit_cast(int, old), __builtin_bit_cast(int, src), CTRL, 0xf, 0xf, false));
}
template <int CTRL> DI f32x4 dppo4(f32x4 o, f32x4 s) { f32x4 r; r.x = dppo<CTRL>(o.x, s.x); r.y = dppo<CTRL>(o.y, s.y); r.z = dppo<CTRL>(o.z, s.z); r.w = dppo<CTRL>(o.w, s.w); return r; }
DI f32x4 sel4(bool c, f32x4 a, f32x4 b) { f32x4 r; r.x = c ? a.x : b.x; r.y = c ? a.y : b.y; r.z = c ? a.z : b.z; r.w = c ? a.w : b.w; return r; }

namespace g8 {
constexpr int BM = 256, BK = 64, HALF = 128, HTB = HALF * BK * 2, RING = 8 * HTB;
DI int lds_byte(int r, int c) { const int st = (r >> 4) * 2 + (c >> 5), rr = r & 15, cc = c & 31, ob = rr * 64 + cc * 2; return st * 1024 + (ob ^ (((ob >> 9) & 1) << 5)); }
DI void stage_rc(int b, int& R, int& C) { const int st = b / 1024, sb = b % 1024, swz = sb ^ (((sb >> 9) & 1) << 5); R = (st >> 1) * 16 + swz / 64; C = (st & 1) * 32 + (swz % 64) / 2; }
DI int perm32(int rho) { const int n = rho >> 4, i = rho & 15; return 8 * (i >> 2) + 4 * n + (i & 3); }

struct UnitD {
    const char* A; const char* B;
    unsigned lda, ldb;
    int nt;
    int pm, pn, sub;
    bool permA;
    int split, slot;
    bool zero, perm;
};
DI void tile_of(int L, int nM, int nN, int& pm, int& pn) {
    const int nwg = nM * nN; int wgid = L;
    { const int q = nwg / 8, r = nwg % 8, xcd = wgid % 8, off = wgid / 8; wgid = (xcd < r ? xcd * (q + 1) : r * (q + 1) + (xcd - r) * q) + off; }
    const int nig = 8 * nN, gid = wgid / nig, fm = gid * 8, gsz = (nM - fm) < 8 ? (nM - fm) : 8;
    pm = fm + ((wgid % nig) % gsz); pn = (wgid % nig) / gsz;
}

template <class P>
DI void run(LAS unsigned char* lds, const P& ph, int tid_in) {
    int tid = tid_in; asm volatile("" : "+v"(tid));
    const int wid = __builtin_amdgcn_readfirstlane(tid >> 6), lane = tid & 63, wr = wid >> 2, wc = wid & 3, fr = lane & 15, fq = lane >> 4;
    int R, C; stage_rc(tid * 16, R, C);
    const int Rp = (R & ~31) + perm32(R & 31);
    const int Ra = (R & ~63) + 4 * (R & 15) + ((R & 63) >> 4);
    const unsigned C2 = (unsigned)C * 2u;
    const unsigned ldsw = (unsigned)wid * 1024u;
    const int aoff = lds_byte(wr * 64 + fr, fq * 8), boff = lds_byte(wc * 32 + fr, fq * 8);
#define G8_SA(b, h) (((b) * 2 + (h)) * HTB)
#define G8_SB(b, h) ((4 + (b) * 2 + (h)) * HTB)
#define G8_STG(bufoff, gp, vo, ld) do { \
        __builtin_amdgcn_global_load_lds((const unsigned*)((gp) + (vo)), (LAS unsigned*)(lds + (bufoff) + ldsw), 16, 0, 0); \
        __builtin_amdgcn_global_load_lds((const unsigned*)((gp) + ((vo) + 64u * (ld))), (LAS unsigned*)(lds + (bufoff) + ldsw + 8192), 16, 0, 0); } while (0)
#define G8_LDA(dst, b, h) do { _Pragma("unroll") for (int m = 0; m < 4; ++m) _Pragma("unroll") for (int k = 0; k < 2; ++k) dst[m][k] = *(const LAS bf16x8*)(lds + G8_SA(b, h) + aoff + m * 2048 + k * 1024); } while (0)
#define G8_LDB(dst, b, h) do { _Pragma("unroll") for (int n = 0; n < 2; ++n) _Pragma("unroll") for (int k = 0; k < 2; ++k) dst[n][k] = *(const LAS bf16x8*)(lds + G8_SB(b, h) + boff + n * 2048 + k * 1024); } while (0)
#define G8_MMA(ai, bj, At, Bt) do { __builtin_amdgcn_s_setprio(1); _Pragma("unroll") for (int m = 0; m < 4; ++m) _Pragma("unroll") for (int n = 0; n < 2; ++n) _Pragma("unroll") for (int k = 0; k < 2; ++k) \
        acc[ai][bj][m][n] = __builtin_amdgcn_mfma_f32_16x16x32_bf16(Bt[n][k], At[m][k], acc[ai][bj][m][n], 0, 0, 0); __builtin_amdgcn_s_setprio(0); } while (0)
#define G8_WAIT_V(n) asm volatile("s_waitcnt vmcnt(" #n ")" ::: "memory")
#define G8_WAIT_L(n) asm volatile("s_waitcnt lgkmcnt(" #n ")" ::: "memory")
#define G8_BAR __builtin_amdgcn_s_barrier()
#define G8_SCHED __builtin_amdgcn_sched_barrier(0)
    UnitD cur, nxt; int ui = 0;
    if (!ph.get(0, cur)) return;
    f32x4 acc[2][2][4][2];
#pragma unroll
    for (int a = 0; a < 2; ++a)
#pragma unroll
        for (int b = 0; b < 2; ++b)
#pragma unroll
            for (int m = 0; m < 4; ++m)
#pragma unroll
                for (int n = 0; n < 2; ++n) acc[a][b][m][n] = (f32x4){0.f, 0.f, 0.f, 0.f};
    bf16x8 At[4][2], B0[2][2], B1[2][2];
    const char* cA = cur.A; const char* cB = cur.B;
    unsigned lda = cur.lda, ldb = cur.ldb;
    unsigned vA = (unsigned)(cur.permA ? Ra : R) * lda + C2, vB = (unsigned)(cur.perm ? Rp : R) * ldb + C2;
    {
        const unsigned hA = 128u * lda, hB = 128u * ldb;
        G8_STG(G8_SB(0, 0), cB, vB, ldb); G8_STG(G8_SB(0, 1), cB + hB, vB, ldb); G8_STG(G8_SA(0, 0), cA, vA, lda); G8_STG(G8_SA(0, 1), cA + hA, vA, lda);
        if (wr == 1) G8_BAR;
        G8_WAIT_V(2); G8_BAR;
        G8_STG(G8_SB(1, 0), cB + 128, vB, ldb); G8_STG(G8_SA(1, 0), cA + 128, vA, lda); G8_STG(G8_SB(1, 1), cB + hB + 128, vB, ldb);
        G8_WAIT_V(6); G8_BAR;
    }
    for (;;) {
        const bool has_next = ph.get(ui + 1, nxt);
        const char* nA = has_next ? nxt.A : cA; const char* nB = has_next ? nxt.B : cB;
        const unsigned nlda = has_next ? nxt.lda : lda, nldb = has_next ? nxt.ldb : ldb;
        const unsigned nvA = (unsigned)((has_next ? nxt.permA : cur.permA) ? Ra : R) * nlda + C2, nvB = (unsigned)((has_next ? nxt.perm : cur.perm) ? Rp : R) * nldb + C2;
        const int nt = cur.nt;
        for (int t = 0; t < nt; t += 2) {
            const bool last = (t == nt - 2);
            const char* a1 = cA + (size_t)(t + 1) * 128;
            const char* a2 = last ? nA : cA + (size_t)(t + 2) * 128; const char* b2 = last ? nB : cB + (size_t)(t + 2) * 128;
            const unsigned xlda = last ? nlda : lda, xldb = last ? nldb : ldb, xvA = last ? nvA : vA, xvB = last ? nvB : vB;
            const unsigned xhA = 128u * xlda, xhB = 128u * xldb;
            const char* a3 = a2 + 128; const char* b3 = b2 + 128;
            G8_LDB(B0, 0, 0); G8_LDB(B1, 0, 1); G8_SCHED; G8_LDA(At, 0, 0); G8_STG(G8_SA(1, 1), a1 + 128u * lda, vA, lda);
            G8_WAIT_V(8); G8_WAIT_L(0); G8_BAR; G8_MMA(0, 0, At, B0); G8_MMA(0, 1, At, B1); G8_BAR; G8_SCHED;
            G8_LDA(At, 0, 1); G8_STG(G8_SB(0, 0), b2, xvB, xldb); G8_STG(G8_SB(0, 1), b2 + xhB, xvB, xldb); G8_STG(G8_SA(0, 0), a2, xvA, xlda);
            G8_WAIT_V(8); G8_WAIT_L(0); G8_BAR; G8_MMA(1, 0, At, B0); G8_MMA(1, 1, At, B1); G8_BAR; G8_SCHED;
            G8_LDB(B0, 1, 0); G8_LDB(B1, 1, 1); G8_SCHED; G8_LDA(At, 1, 0); G8_STG(G8_SA(0, 1), a2 + xhA, xvA, xlda);
            G8_WAIT_V(8); G8_WAIT_L(0); G8_BAR; G8_MMA(0, 0, At, B0); G8_MMA(0, 1, At, B1); G8_BAR; G8_SCHED;
            G8_LDA(At, 1, 1); G8_STG(G8_SB(1, 0), b3, xvB, xldb); G8_STG(G8_SB(1, 1), b3 + xhB, xvB, xldb); G8_STG(G8_SA(1, 0), a3, xvA, xlda);
            G8_WAIT_V(8); G8_WAIT_L(0); G8_BAR; G8_MMA(1, 0, At, B0); G8_MMA(1, 1, At, B1); G8_BAR; G8_SCHED;
        }
        if (wr == 0) G8_BAR;
        ph.epi(acc, cur, lds, tid, wid, lane, wr, wc, fr, fq);
        if (!has_next) break;
        if (nxt.zero) {
#pragma unroll
            for (int a = 0; a < 2; ++a)
#pragma unroll
                for (int b = 0; b < 2; ++b)
#pragma unroll
                    for (int m = 0; m < 4; ++m)
#pragma unroll
                        for (int n = 0; n < 2; ++n) acc[a][b][m][n] = (f32x4){0.f, 0.f, 0.f, 0.f};
        }
        cur = nxt; cA = nA; cB = nB; lda = nlda; ldb = nldb; vA = nvA; vB = nvB; ++ui;
        if (wr == 1) G8_BAR;
    }
    G8_WAIT_V(0);
    G8_BAR;
#undef G8_SA
#undef G8_SB
#undef G8_STG
#undef G8_LDA
#undef G8_LDB
#undef G8_MMA
#undef G8_WAIT_V
#undef G8_WAIT_L
#undef G8_BAR
#undef G8_SCHED
}
}
using g8::UnitD;
typedef f32x4 Acc[2][2][4][2];

struct Args { const float* in[27]; float* out; unsigned char* ws; };
struct Ctx {
    const Args& a;
    unsigned char* ws; float* out;
    int G, bid, layer;
};
DI bf16_t* wt_ptr(const Ctx& c, size_t off) { return (bf16_t*)(c.ws + WS_WT) + (size_t)c.layer * W_LAYER + off; }
DI bf16_t* XBp(const Ctx& c) { return (bf16_t*)(c.ws + WS_XB); }
DI bf16_t* Hp(const Ctx& c) { return (bf16_t*)(c.ws + WS_H); }
DI float* XFp(const Ctx& c) { return c.out + O_Y; }
DI float* HALOp(const Ctx& c) { return (float*)(c.ws + WS_HALO); }


DI bool splitk_combine(Acc& acc, unsigned char* ws, const UnitD& u, int inst, int tid, int wid, int lane) {
    unsigned long long* buf = (unsigned long long*)(ws + WS_PART) + (size_t)u.slot * 64 * 512;
    unsigned* flag = (unsigned*)(ws + WS_PFLAG) + (inst * 16 + u.slot) * 64;
    const bool sec = (u.split == 2);
    if (!sec) {
        if (wid == 0) { unsigned sp = 0; while ((unsigned)__builtin_amdgcn_readfirstlane(__hip_atomic_load(flag, __ATOMIC_RELAXED, __HIP_MEMORY_SCOPE_AGENT)) < 8u) { __builtin_amdgcn_s_sleep(2); if (++sp > (1u << 22)) break; } }
        asm volatile("s_waitcnt vmcnt(0) lgkmcnt(0)" ::: "memory"); __builtin_amdgcn_s_barrier(); asm volatile("" ::: "memory");
    }
#pragma unroll
    for (int ai = 0; ai < 2; ++ai)
#pragma unroll
        for (int bj = 0; bj < 2; ++bj) {
            unsigned long long* p = (buf + ((ai * 2 + bj) * 16) * 512) + tid;
            if (sec) {
#pragma unroll
                for (int m = 0; m < 4; ++m)
#pragma unroll
                    for (int n = 0; n < 2; ++n) { const f32x4 v = acc[ai][bj][m][n]; const int q = (m * 2 + n) * 2;
                        __hip_atomic_store(p + q * 512, ((unsigned long long)__float_as_uint(v.y) << 32) | __float_as_uint(v.x), __ATOMIC_RELAXED, __HIP_MEMORY_SCOPE_AGENT);
                        __hip_atomic_store(p + (q + 1) * 512, ((unsigned long long)__float_as_uint(v.w) << 32) | __float_as_uint(v.z), __ATOMIC_RELAXED, __HIP_MEMORY_SCOPE_AGENT); }
            } else {
                unsigned long long w[16];
#pragma unroll
                for (int q = 0; q < 16; ++q) w[q] = __hip_atomic_load(p + q * 512, __ATOMIC_RELAXED, __HIP_MEMORY_SCOPE_AGENT);
#pragma unroll
                for (int m = 0; m < 4; ++m)
#pragma unroll
                    for (int n = 0; n < 2; ++n) { const int q = (m * 2 + n) * 2;
                        acc[ai][bj][m][n] += (f32x4){__uint_as_float((unsigned)w[q]), __uint_as_float((unsigned)(w[q] >> 32)), __uint_as_float((unsigned)w[q + 1]), __uint_as_float((unsigned)(w[q + 1] >> 32))}; }
            }
            asm volatile("" ::: "memory");
        }
    if (sec) {
        asm volatile("s_waitcnt vmcnt(0)" ::: "memory");
        if (lane == 0) __hip_atomic_fetch_add(flag, 1u, __ATOMIC_RELAXED, __HIP_MEMORY_SCOPE_AGENT);
    }
    return sec;
}

DI void store_tile_bf16_perm(const Acc& acc, bf16_t* base  , size_t ld, int wr, int wc, int fr, int fq) {
#pragma unroll
    for (int ai = 0; ai < 2; ++ai)
#pragma unroll
        for (int m = 0; m < 4; ++m) {
            bf16_t* rowp = base + (size_t)(ai * 128 + wr * 64 + m * 16 + fr) * ld + wc * 32 + 8 * fq;
#pragma unroll
            for (int bj = 0; bj < 2; ++bj) {
                const f32x4 v0 = acc[ai][bj][m][0], v1 = acc[ai][bj][m][1];
                u32x4 w; w.x = cvt_pk_bf16(v0[0], v0[1]); w.y = cvt_pk_bf16(v0[2], v0[3]); w.z = cvt_pk_bf16(v1[0], v1[1]); w.w = cvt_pk_bf16(v1[2], v1[3]);
                *(u32x4*)(rowp + bj * 128) = w;
            }
        }
}

struct PhIn {
    Ctx c;
    DI bool get(int i, UnitD& u) const {
        const long L = (long)i * c.G + c.bid; if (L >= 132 * 25) return false;
        int pm, pn; g8::tile_of((int)L, 132, 25, pm, pn);
        u.A = (const char*)(XBp(c) + (size_t)pm * 256 * DM); u.B = (const char*)(wt_ptr(c, W_IN) + (size_t)pn * 256 * DM);
        u.lda = DM * 2; u.ldb = DM * 2; u.nt = DM / 64; u.pm = pm; u.pn = pn; u.sub = 0; u.split = 0; u.slot = 0; u.permA = false; u.zero = true; u.perm = true; return true;
    }
    DI void epi(Acc& acc, const UnitD& u, LAS unsigned char* lds, int tid, int wid, int lane, int wr, int wc, int fr, int fq) const {
        asm volatile("" : "+v"(fr), "+v"(fq), "+v"(tid));
        const bool isG = u.pn >= 13;
        const int gc = (isG ? (u.pn - 13) * 256 : 0) + wc * 32 + 8 * fq;
        const float* bg = c.a.in[8] + (size_t)c.layer * NGATE + gc;
        unsigned char* gbase = c.ws + WS_GS + (size_t)u.pm * 256 * NGATE + gc;
        bf16_t* hbase = Hp(c) + (size_t)u.pm * 256 * LDH + (isG ? 0 : u.pn * 256) + wc * 32 + 8 * fq;
#pragma unroll
        for (int ai = 0; ai < 2; ++ai)
#pragma unroll
            for (int m = 0; m < 4; ++m) {
                const int row = ai * 128 + wr * 64 + m * 16 + fr;
#pragma unroll
                for (int bj = 0; bj < 2; ++bj) {
                    f32x4 v0 = acc[ai][bj][m][0], v1 = acc[ai][bj][m][1];
                    if (isG) {
                        const f32x4 nb0 = *(const f32x4*)(bg + bj * 128) * -1.44269504089f, nb1 = *(const f32x4*)(bg + bj * 128 + 4) * -1.44269504089f;
                        unsigned q[8];
#pragma unroll
                        for (int e = 0; e < 4; ++e) {
                            const float t0 = __builtin_amdgcn_exp2f(__builtin_fmaf(v0[e], -1.44269504089f, nb0[e])), t1 = __builtin_amdgcn_exp2f(__builtin_fmaf(v1[e], -1.44269504089f, nb1[e]));
                            const unsigned a0 = (unsigned)__builtin_fmaf(__builtin_amdgcn_rcpf(1.f + t0), 255.f, 0.5f), a1 = (unsigned)__builtin_fmaf(__builtin_amdgcn_rcpf(1.f + t1), 255.f, 0.5f);
                            q[e] = a0 > 1u ? a0 : 1u; q[4 + e] = a1 > 1u ? a1 : 1u;
                        }
                        u32x2 w; w.x = q[0] | (q[1] << 8) | (q[2] << 16) | (q[3] << 24); w.y = q[4] | (q[5] << 8) | (q[6] << 16) | (q[7] << 24);
                        *(u32x2*)(gbase + (size_t)row * NGATE + bj * 128) = w;
                    } else {
                        u32x4 w; w.x = cvt_pk_bf16(v0[0], v0[1]); w.y = cvt_pk_bf16(v0[2], v0[3]); w.z = cvt_pk_bf16(v1[0], v1[1]); w.w = cvt_pk_bf16(v1[2], v1[3]);
                        *(u32x4*)(hbase + (size_t)row * LDH + bj * 128) = w;
                    }
                }
            }
    }
};

struct PhMerge {
    Ctx c;
    DI bool get(int i, UnitD& u) const {
        const int ti = i / 3, j = i - ti * 3;
        const int full = 528 / c.G, tail = 528 - full * c.G;
        int L, kh = 0; u.split = 0; u.slot = 0; u.permA = false;
        if (ti < full) L = ti * c.G + c.bid;
        else if (ti == full && 2 * tail <= c.G && tail <= 16) { if (c.bid >= 2 * tail) return false; L = full * c.G + (c.bid >> 1); kh = c.bid & 1; u.split = 1 + kh; u.slot = c.bid >> 1; }
        else if (ti == full) { L = ti * c.G + c.bid; if (L >= 528) return false; }
        else return false;
        int pm, pn; g8::tile_of(L, 132, 4, pm, pn);
        u.pm = pm; u.pn = pn; u.sub = j; u.perm = true;
        const int co = j == 0 ? QO : (j == 1 ? GUO : SBO);
        const int kn = u.split ? 256 : 512;
        u.A = (const char*)(Hp(c) + (size_t)pm * 256 * LDH + co + kh * kn); u.B = (const char*)(wt_ptr(c, W_PA) + (size_t)j * 512 * 1024 + (size_t)pn * 256 * 512 + kh * kn);
        u.lda = LDH * 2; u.ldb = 512 * 2; u.nt = kn / 64; u.zero = (j == 0);
        return true;
    }
    DI void epi(Acc& acc, const UnitD& u, LAS unsigned char* lds, int tid, int wid, int lane, int wr, int wc, int fr, int fq) const {
        asm volatile("" : "+v"(fr), "+v"(fq), "+v"(tid));
        const int j = u.sub; const bool lastj = (j == 2);
        const unsigned char* gp = c.ws + WS_GS + (size_t)(u.pm * 256 + wr * 64 + fr) * NGATE + j * 1024 + u.pn * 256 + wc * 32 + 8 * fq;
        u32x2 qa[16], qb[16];
#pragma unroll
        for (int ai = 0; ai < 2; ++ai)
#pragma unroll
            for (int m = 0; m < 4; ++m)
#pragma unroll
                for (int bj = 0; bj < 2; ++bj) {
                    const int k = (ai * 4 + m) * 2 + bj;
                    const unsigned char* p = gp + (size_t)(ai * 128 + m * 16) * NGATE + bj * 128;
                    qa[k] = *(const u32x2*)p;
                    qb[k] = (u32x2){0xffffffffu, 0xffffffffu};
                    if (!lastj) qb[k] = *(const u32x2*)(p + 1024);
                }
        asm volatile("" ::: "memory");
#pragma unroll
        for (int ai = 0; ai < 2; ++ai)
#pragma unroll
            for (int m = 0; m < 4; ++m)
#pragma unroll
                for (int bj = 0; bj < 2; ++bj) {
                    const int k = (ai * 4 + m) * 2 + bj;
                    const u32x2 a = qa[k], b = qb[k];
                    f32x4 s0, s1;
                    s0[0] = (float)(a.x & 0xff) * __builtin_amdgcn_rcpf((float)(b.x & 0xff)); s0[1] = (float)((a.x >> 8) & 0xff) * __builtin_amdgcn_rcpf((float)((b.x >> 8) & 0xff));
                    s0[2] = (float)((a.x >> 16) & 0xff) * __builtin_amdgcn_rcpf((float)((b.x >> 16) & 0xff)); s0[3] = (float)(a.x >> 24) * __builtin_amdgcn_rcpf((float)(b.x >> 24));
                    s1[0] = (float)(a.y & 0xff) * __builtin_amdgcn_rcpf((float)(b.y & 0xff)); s1[1] = (float)((a.y >> 8) & 0xff) * __builtin_amdgcn_rcpf((float)((b.y >> 8) & 0xff));
                    s1[2] = (float)((a.y >> 16) & 0xff) * __builtin_amdgcn_rcpf((float)((b.y >> 16) & 0xff)); s1[3] = (float)(a.y >> 24) * __builtin_amdgcn_rcpf((float)(b.y >> 24));
                    acc[ai][bj][m][0] *= s0; acc[ai][bj][m][1] *= s1;
                }
        if (lastj) {
            if (u.split && splitk_combine(acc, c.ws, u, c.layer * 3 + 0, tid, wid, lane)) return;
            store_tile_bf16_perm(acc, Hp(c) + (size_t)u.pm * 256 * LDH + MGO + u.pn * 256, LDH, wr, wc, fr, fq);
        }
    }
};

typedef float f32x2v __attribute__((ext_vector_type(2)));
struct PhRes {
    Ctx c; int which;
    DI bool get(int i, UnitD& u) const {
        const int vcu = (c.G & 7) == 0 ? (c.bid & 7) * (c.G >> 3) + (c.bid >> 3) : c.bid;
        const int full = 528 / c.G, tail = 528 - full * c.G;
        int L, kh = 0; u.split = 0; u.slot = 0; u.permA = false;
        if (i < full) L = i * c.G + vcu;
        else if (i == full && 2 * tail <= c.G && tail <= 16) { if (vcu >= 2 * tail) return false; L = full * c.G + (vcu >> 1); kh = vcu & 1; u.split = 1 + kh; u.slot = vcu >> 1; }
        else if (i == full) { L = i * c.G + vcu; if (L >= 528) return false; }
        else return false;
        const int pm = L >> 2, pn = L & 3;
        u.pm = pm; u.pn = pn; u.sub = 0; u.zero = true; u.perm = true;
        if (which == 0) { const int kn = u.split ? 512 : 1024; u.A = (const char*)(Hp(c) + (size_t)pm * 256 * LDH + MGO + kh * kn); u.lda = LDH * 2; u.B = (const char*)(wt_ptr(c, W_O) + (size_t)pn * 256 * 1024 + kh * kn); u.ldb = 1024 * 2; u.nt = kn / 64; }
        else { const int kn = u.split ? DFF / 2 : DFF; u.A = (const char*)(Hp(c) + (size_t)pm * 256 * DFF + kh * kn); u.lda = DFF * 2; u.B = (const char*)(wt_ptr(c, W_DN) + (size_t)pn * 256 * DFF + kh * kn); u.ldb = DFF * 2; u.nt = kn / 64; }
        return true;
    }
    DI void epi(Acc& acc, const UnitD& u, LAS unsigned char* lds, int tid, int wid, int lane, int wr, int wc, int fr, int fq) const {
        asm volatile("" : "+v"(fr), "+v"(fq), "+v"(tid), "+v"(lane));
        if (u.split && splitk_combine(acc, c.ws, u, c.layer * 3 + 1 + which, tid, wid, lane)) return;
        float* outp = XFp(c) + (size_t)u.pm * 256 * DM;
        bf16_t* outb = XBp(c) + (size_t)u.pm * 256 * DM;
        const bool final_out = (which == 1 && c.layer == 1);
        const int col0 = u.pn * 256 + wc * 32 + 8 * fq;
        const unsigned loff = (unsigned)((wr * 64 + fr) * DM + col0);
#pragma unroll
        for (int ai = 0; ai < 2; ++ai) {
            u32x4 r[4][2];
#pragma unroll
            for (int m = 0; m < 4; ++m)
#pragma unroll
                for (int bj = 0; bj < 2; ++bj) r[m][bj] = *(const u32x4*)((outb + ((ai * 128 + m * 16) * DM + bj * 128)) + loff);
            asm volatile("" ::: "memory");
#pragma unroll
            for (int m = 0; m < 4; ++m)
#pragma unroll
                for (int bj = 0; bj < 2; ++bj) { const u32x4 w = r[m][bj];
                    acc[ai][bj][m][0] = (f32x4){bf_lo(w.x), bf_hi(w.x), bf_lo(w.y), bf_hi(w.y)} * ALPHA + acc[ai][bj][m][0];
                    acc[ai][bj][m][1] = (f32x4){bf_lo(w.z), bf_hi(w.z), bf_lo(w.w), bf_hi(w.w)} * ALPHA + acc[ai][bj][m][1]; }
            asm volatile("" ::: "memory");
        }
        const float* lg = c.a.in[which == 0 ? 19 : 25] + c.layer * DM + col0; const float* lb = c.a.in[which == 0 ? 20 : 26] + c.layer * DM + col0;
        f32x4 g4[2][2], b4[2][2];
#pragma unroll
        for (int bj = 0; bj < 2; ++bj)
#pragma unroll
            for (int n = 0; n < 2; ++n) { g4[bj][n] = *(const f32x4*)(lg + bj * 128 + n * 4); b4[bj][n] = *(const f32x4*)(lb + bj * 128 + n * 4); }
        LAS f32x2v* P = (LAS f32x2v*)(lds + XL_OFF);
        LAS f32x2v* S = (LAS f32x2v*)(lds + XL_OFF + 8192);
        const int inst = c.layer * 2 + which;
        unsigned long long* xbuf = (unsigned long long*)(c.ws + WS_XBUF + (size_t)inst * XBUF_INST);
        unsigned* cnt = (unsigned*)(c.ws + WS_CNT) + ((size_t)inst * 132 + u.pm) * 64;
#pragma unroll
        for (int ai = 0; ai < 2; ++ai)
#pragma unroll
            for (int m = 0; m < 4; ++m) {
                float sm = 0.f;
#pragma unroll
                for (int bj = 0; bj < 2; ++bj)
#pragma unroll
                    for (int n = 0; n < 2; ++n) { const f32x4 x = acc[ai][bj][m][n]; sm += (x[0] + x[1]) + (x[2] + x[3]); }
                sm += __shfl_xor(sm, 16); sm += __shfl_xor(sm, 32);
                const float mw = sm * (1.0f / 64.0f); float q = 0.f;
#pragma unroll
                for (int bj = 0; bj < 2; ++bj)
#pragma unroll
                    for (int n = 0; n < 2; ++n) { const f32x4 d = acc[ai][bj][m][n] - mw; q += (d[0] * d[0] + d[1] * d[1]) + (d[2] * d[2] + d[3] * d[3]); }
                q += __shfl_xor(q, 16); q += __shfl_xor(q, 32);
                P[(ai * 128 + wr * 64 + m * 16 + fr) * 4 + wc] = (f32x2v){mw, q};
            }
        asm volatile("s_waitcnt lgkmcnt(0)" ::: "memory"); __builtin_amdgcn_s_barrier(); asm volatile("" ::: "memory");
        const int prow = wid * 32 + (lane & 31);
        if (lane < 32) {
            const f32x2v a = P[prow * 4 + 0], b = P[prow * 4 + 1], cc = P[prow * 4 + 2], d = P[prow * 4 + 3];
            const float mt = (a.x + b.x + cc.x + d.x) * 0.25f;
            const float da = a.x - mt, db = b.x - mt, dc = cc.x - mt, dd = d.x - mt;
            const float m2 = (a.y + b.y) + (cc.y + d.y) + 64.0f * ((da * da + db * db) + (dc * dc + dd * dd));
            __hip_atomic_store(xbuf + ((size_t)(u.pm * 256 + prow) * 4 + u.pn), ((unsigned long long)__float_as_uint(m2) << 32) | __float_as_uint(mt), __ATOMIC_RELAXED, __HIP_MEMORY_SCOPE_AGENT);
        }
        asm volatile("s_waitcnt vmcnt(0)" ::: "memory");
        if (lane == 0) __hip_atomic_fetch_add(cnt, 1u, __ATOMIC_RELAXED, __HIP_MEMORY_SCOPE_AGENT);
        if (wid == 0) {
            unsigned sp = 0;
            while ((unsigned)__builtin_amdgcn_readfirstlane(__hip_atomic_load(cnt, __ATOMIC_RELAXED, __HIP_MEMORY_SCOPE_AGENT)) < 32u) { __builtin_amdgcn_s_sleep(2); if (++sp > (1u << 22)) break; }
        }
        asm volatile("s_waitcnt vmcnt(0) lgkmcnt(0)" ::: "memory"); __builtin_amdgcn_s_barrier(); asm volatile("" ::: "memory");
        if (lane < 32) {
            const unsigned long long* slot = xbuf + (size_t)(u.pm * 256 + prow) * 4;
            float mt[4], m2[4]; float ms = 0.f;
#pragma unroll
            for (int t = 0; t < 4; ++t) { const unsigned long long w = __hip_atomic_load(slot + t, __ATOMIC_RELAXED, __HIP_MEMORY_SCOPE_AGENT); mt[t] = __uint_as_float((unsigned)w); m2[t] = __uint_as_float((unsigned)(w >> 32)); ms += mt[t]; }
            const float mean = ms * 0.25f; float q = 0.f;
#pragma unroll
            for (int t = 0; t < 4; ++t) { const float dm = mt[t] - mean; q += m2[t] + 256.0f * dm * dm; }
            S[prow] = (f32x2v){mean, 1.0f / sqrtf(q * (1.0f / 1024.0f) + LN_EPS)};
        }
        asm volatile("s_waitcnt lgkmcnt(0)" ::: "memory"); __builtin_amdgcn_s_barrier(); asm volatile("" ::: "memory");
#pragma unroll
        for (int ai = 0; ai < 2; ++ai)
#pragma unroll
            for (int m = 0; m < 4; ++m) {
                const int r = ai * 128 + wr * 64 + m * 16 + fr; const f32x2v sr = S[r];
#pragma unroll
                for (int bj = 0; bj < 2; ++bj) {
                    const f32x4 o0 = (acc[ai][bj][m][0] - sr.x) * sr.y * g4[bj][0] + b4[bj][0], o1 = (acc[ai][bj][m][1] - sr.x) * sr.y * g4[bj][1] + b4[bj][1];
                    if (final_out) { float* yp = (outp + ((ai * 128 + m * 16) * DM + bj * 128)) + loff; *(f32x4*)yp = o0; *(f32x4*)(yp + 4) = o1; }
                    else { u32x4 w; w.x = cvt_pk_bf16(o0[0], o0[1]); w.y = cvt_pk_bf16(o0[2], o0[3]); w.z = cvt_pk_bf16(o1[0], o1[1]); w.w = cvt_pk_bf16(o1[2], o1[3]);
                        *(u32x4*)((outb + ((ai * 128 + m * 16) * DM + bj * 128)) + loff) = w; }
                }
                if (m & 1) asm volatile("" ::: "memory");
            }
    }
};

struct PhUp {
    Ctx c;
    DI bool get(int i, UnitD& u) const {
        const long L = (long)i * c.G + c.bid; if (L >= 132 * 22) return false;
        int pm, pn; g8::tile_of((int)L, 132, 22, pm, pn);
        u.A = (const char*)(XBp(c) + (size_t)pm * 256 * DM); u.B = (const char*)(wt_ptr(c, W_UP) + (size_t)pn * 256 * DM);
        u.lda = DM * 2; u.ldb = DM * 2; u.nt = DM / 64; u.pm = pm; u.pn = pn; u.sub = 0; u.split = 0; u.slot = 0; u.zero = true; u.perm = true; u.permA = true; return true;
    }
    DI void epi(Acc& acc, const UnitD& u, LAS unsigned char* lds, int tid, int wid, int lane, int wr, int wc, int fr, int fq) const {
        asm volatile("" : "+v"(fr), "+v"(fq), "+v"(tid));
        LAS float* HL = (LAS float*)(lds + HL_OFF);
        const bool samp = u.pm >= 128;
        const int tcol = wc * 32 + 8 * fq;
        const int ocol = u.pn * 128 + tcol;
        if (fr == 15) {
#pragma unroll
            for (int ai = 0; ai < 2; ++ai)
#pragma unroll
                for (int bj = 0; bj < 2; ++bj)
#pragma unroll
                    for (int n = 0; n < 2; ++n) {
                        *(LAS f32x4*)(HL + ((ai * 2 + wr) * 2 + 0) * 256 + bj * 128 + tcol + 4 * n) = acc[ai][bj][2][n];
                        *(LAS f32x4*)(HL + ((ai * 2 + wr) * 2 + 1) * 256 + bj * 128 + tcol + 4 * n) = acc[ai][bj][3][n];
                    }
        }
        asm volatile("s_waitcnt lgkmcnt(0)" ::: "memory"); __builtin_amdgcn_s_barrier(); asm volatile("" ::: "memory");
        const float* cw = c.a.in[22] + (size_t)c.layer * 3 * NUP; const float* cb = c.a.in[23] + (size_t)c.layer * NUP;
        float* halo = HALOp(c) + (size_t)u.pm * 4 * NUP;
        bf16_t* act = Hp(c) + (size_t)u.pm * 256 * DFF + u.pn * 128 + wc * 32 + 4 * fq;
        const bool even = (fr & 1) == 0;
        const f32x4 zero4 = {0.f, 0.f, 0.f, 0.f};
#pragma unroll
        for (int n = 0; n < 2; ++n) {
            f32x4 w0[2], w1[2], w2[2], bb[2];
#pragma unroll
            for (int bj = 0; bj < 2; ++bj) { const int oc = ocol + bj * DFF + 4 * n; w0[bj] = *(const f32x4*)(cw + oc); w1[bj] = *(const f32x4*)(cw + NUP + oc); w2[bj] = *(const f32x4*)(cw + 2 * NUP + oc); bb[bj] = *(const f32x4*)(cb + oc); }
#pragma unroll
            for (int ai = 0; ai < 2; ++ai) {
                const int row0 = ai * 128 + wr * 64 + 4 * fr;
                f32x4 cv[4][2];
#pragma unroll
                for (int bj = 0; bj < 2; ++bj) {
                    const int oc = ocol + bj * DFF + 4 * n;
                    f32x4 o3 = zero4, o2 = zero4;
                    f32x4 past0 = zero4, past1 = zero4;
                    if (!samp) {
                        const int sblk = ai * 2 + wr - 1;
                        if (sblk >= 0) { o2 = *(const LAS f32x4*)(HL + (sblk * 2 + 0) * 256 + bj * 128 + tcol + 4 * n); o3 = *(const LAS f32x4*)(HL + (sblk * 2 + 1) * 256 + bj * 128 + tcol + 4 * n); }
                    } else if (even) {
                        const int bglob = ((u.pm - 128) * 256 + row0) >> 3;
                        const float* st = c.a.in[5] + ((size_t)(c.layer * DB + bglob) * 2) * NUP + oc;
                        past0 = *(const f32x4*)st; past1 = *(const f32x4*)(st + NUP);
                    }
                    const f32x4 v0 = acc[ai][bj][0][n], v1 = acc[ai][bj][1][n], v2 = acc[ai][bj][2][n], v3 = acc[ai][bj][3][n];
                    f32x4 s3 = dppo4<0x111>(o3, v3), s2 = dppo4<0x111>(o2, v2);
                    f32x4 p1_0 = s3, p2_0 = s2, p2_1 = s3;
                    if (samp && even) { p1_0 = past1; p2_0 = past0; p2_1 = past1; }
                    cv[0][bj] = w0[bj] * p2_0 + w1[bj] * p1_0 + w2[bj] * v0 + bb[bj];
                    cv[1][bj] = w0[bj] * p2_1 + w1[bj] * v0 + w2[bj] * v1 + bb[bj];
                    cv[2][bj] = w0[bj] * v0 + w1[bj] * v1 + w2[bj] * v2 + bb[bj];
                    cv[3][bj] = w0[bj] * v1 + w1[bj] * v2 + w2[bj] * v3 + bb[bj];
                    if (!samp) {
                        if (ai == 0 && wr == 0 && fr == 0) { *(f32x4*)(halo + oc) = v0; *(f32x4*)(halo + (size_t)NUP + oc) = v1; }
                        if (ai == 1 && wr == 1 && fr == 15) {
                            *(f32x4*)(halo + (size_t)2 * NUP + oc) = v2; *(f32x4*)(halo + (size_t)3 * NUP + oc) = v3;
                            if ((u.pm & 7) == 7) { float* fo = c.out + O_FCP + ((size_t)(c.layer * NB + (u.pm >> 3)) * 2) * NUP + oc; *(f32x4*)fo = v2; *(f32x4*)(fo + NUP) = v3; }
                        }
                    } else if (!even) {
                        const int bglob = ((u.pm - 128) * 256 + row0) >> 3;
                        float* fo = c.out + O_FCS + ((size_t)(c.layer * DB + bglob) * 2) * NUP + oc; *(f32x4*)fo = v2; *(f32x4*)(fo + NUP) = v3;
                    }
                }
#pragma unroll
                for (int m = 0; m < 4; ++m) {
                    f32x4 o;
#pragma unroll
                    for (int e = 0; e < 4; ++e) { const float g = cv[m][1][e]; o[e] = cv[m][0][e] * g * __builtin_amdgcn_rcpf(1.f + fast_exp(-g)); }
                    u32x2 w; w.x = cvt_pk_bf16(o[0], o[1]); w.y = cvt_pk_bf16(o[2], o[3]);
                    *(u32x2*)(act + (size_t)(row0 + m) * DFF + 16 * n) = w;
                }
            }
        }
    }
};

DI void transpose_item(const float* W, int K, int N, bf16_t* WT, int mode, LAS float* scr, int item, int lane) {
    const int nblk = N / 32, kb = item / nblk, nb = item % nblk, k0 = 64 * kb, n0 = 32 * nb;
    float wv[32];
#pragma unroll
    for (int i = 0; i < 32; ++i) wv[i] = W[(size_t)(k0 + 2 * i + (lane >> 5)) * N + n0 + (lane & 31)];
#pragma unroll
    for (int i = 0; i < 32; ++i) scr[(2 * i + (lane >> 5)) * 33 + (lane & 31)] = wv[i];
    asm volatile("s_waitcnt lgkmcnt(0)" ::: "memory");
    int r0 = n0;
    if (mode == 1) { const int half = n0 / DFF, cc = n0 - half * DFF; r0 = (cc / 128) * 256 + half * 128 + (cc & 127); }
    const int cch = lane & 7;
#pragma unroll
    for (int j = 0; j < 4; ++j) { const int n = (lane >> 3) + 8 * j; const LAS float* s = scr + (8 * cch) * 33 + n;
        u32x4 o; o.x = cvt_pk_bf16(s[0 * 33], s[1 * 33]); o.y = cvt_pk_bf16(s[2 * 33], s[3 * 33]); o.z = cvt_pk_bf16(s[4 * 33], s[5 * 33]); o.w = cvt_pk_bf16(s[6 * 33], s[7 * 33]);
        if (mode == 2) {
            bf16_t* wp = WT + (size_t)(r0 + n) * K + k0 + 32 * (cch >> 2) + 4 * (cch & 3);
            *(u32x2*)wp = (u32x2){o.x, o.y}; *(u32x2*)(wp + 16) = (u32x2){o.z, o.w};
        } else *(u32x4*)(WT + (size_t)(r0 + n) * K + k0 + 8 * cch) = o; }
    asm volatile("s_waitcnt lgkmcnt(0)" ::: "memory");
}
constexpr int CW_IN = 16 * (NIN / 32), CW_G = 16 * (NGATE / 32), CW_P = 8 * 32, CW_O = 16 * 32, CW_UP = 16 * (NUP / 32), CW_DN = (DFF / 64) * 32;
constexpr int CW_A = CW_IN + CW_G + 3 * CW_P  , CW_B = CW_A + CW_O + CW_UP  , CW_ALL = CW_B + CW_DN;
DI void convert_layer_weights(const Ctx& c, int l, LAS float* scr, int gw, int NGW, int lane, int it_lo = 0, int it_hi = 1 << 30) {
    constexpr int I_IN = 16 * (NIN / 32), I_G = 16 * (NGATE / 32), I_P = 8 * 32, I_O = 16 * 32, I_UP = 16 * (NUP / 32), I_DN = (DFF / 64) * 32;
    constexpr int I_LAYER = I_IN + I_G + 3 * I_P + I_O + I_UP + I_DN;
    bf16_t* wt = (bf16_t*)(c.ws + WS_WT) + (size_t)l * W_LAYER;
    const int hi_ = it_hi < I_LAYER ? it_hi : I_LAYER;
    for (int it = it_lo + gw; it < hi_; it += NGW) {
        int r = it;
        if (r < I_IN) { transpose_item(c.a.in[6] + (size_t)l * DM * NIN, DM, NIN, wt + W_IN, 0, scr, r, lane); continue; } r -= I_IN;
        if (r < I_G) { transpose_item(c.a.in[7] + (size_t)l * DM * NGATE, DM, NGATE, wt + W_G, 0, scr, r, lane); continue; } r -= I_G;
        if (r < I_P) { transpose_item(c.a.in[15] + (size_t)l * 512 * 1024, 512, 1024, wt + W_PA, 0, scr, r, lane); continue; } r -= I_P;
        if (r < I_P) { transpose_item(c.a.in[16] + (size_t)l * 512 * 1024, 512, 1024, wt + W_PG, 0, scr, r, lane); continue; } r -= I_P;
        if (r < I_P) { transpose_item(c.a.in[17] + (size_t)l * 512 * 1024, 512, 1024, wt + W_PC, 0, scr, r, lane); continue; } r -= I_P;
        if (r < I_O) { transpose_item(c.a.in[18] + (size_t)l * 1024 * 1024, 1024, 1024, wt + W_O, 0, scr, r, lane); continue; } r -= I_O;
        if (r < I_UP) { transpose_item(c.a.in[21] + (size_t)l * DM * NUP, DM, NUP, wt + W_UP, 1, scr, r, lane); continue; } r -= I_UP;
        transpose_item(c.a.in[24] + (size_t)l * DFF * DM, DFF, DM, wt + W_DN, 2, scr, r, lane);
    }
}
DI void phase_prologue(const Ctx& c, LAS unsigned char* lds, int tid) {
    const int wave = tid >> 6, lane = tid & 63;
    LAS float* scr = (LAS float*)(lds + wave * 16384);
    const int gw = c.bid * 8 + wave, NGW = c.G * 8;
    convert_layer_weights(c, 0, scr, gw, NGW, lane, 0, CW_A);
    for (int m0 = gw * 4; m0 < MT; m0 += NGW * 4) {
        const float* src = m0 < MP ? c.a.in[0] + (size_t)m0 * DM : c.a.in[1] + (size_t)(m0 - MP) * DM;
        bf16_t* dst = XBp(c) + (size_t)m0 * DM;
        f32x4 v[4][4];
#pragma unroll
        for (int r = 0; r < 4; ++r)
#pragma unroll
            for (int j = 0; j < 4; ++j) v[r][j] = *(const f32x4*)(src + (size_t)r * DM + 4 * lane + 256 * j);
#pragma unroll
        for (int r = 0; r < 4; ++r)
#pragma unroll
            for (int j = 0; j < 4; ++j) { u32x2 w; w.x = cvt_pk_bf16(v[r][j].x, v[r][j].y); w.y = cvt_pk_bf16(v[r][j].z, v[r][j].w); *(u32x2*)(dst + (size_t)r * DM + 4 * lane + 256 * j) = w; }
    }
}

DI void phase_ln(const Ctx& c, const float* g, const float* b, int tid) {
    const int wave = tid >> 6, lane = tid & 63;
    const int gw = c.bid * 8 + wave, NGW = c.G * 8;
    f32x4 gv[4], bv[4];
#pragma unroll
    for (int j = 0; j < 4; ++j) { gv[j] = *(const f32x4*)(g + 4 * lane + 256 * j); bv[j] = *(const f32x4*)(b + 4 * lane + 256 * j); }
    for (int m = gw; m < MT; m += NGW) {
        float* xr = XFp(c) + (size_t)m * DM; bf16_t* xb = XBp(c) + (size_t)m * DM;
        f32x4 v[4]; float s = 0.f;
#pragma unroll
        for (int j = 0; j < 4; ++j) { v[j] = *(const f32x4*)(xr + 4 * lane + 256 * j); s += (v[j].x + v[j].y) + (v[j].z + v[j].w); }
        const float mean = wave_sum(s) * (1.f / DM); float s2 = 0.f;
#pragma unroll
        for (int j = 0; j < 4; ++j) { v[j] = v[j] - mean; s2 += (v[j].x * v[j].x + v[j].y * v[j].y) + (v[j].z * v[j].z + v[j].w * v[j].w); }
        const float rstd = 1.f / sqrtf(wave_sum(s2) * (1.f / DM) + LN_EPS);
#pragma unroll
        for (int j = 0; j < 4; ++j) { const f32x4 o = v[j] * rstd * gv[j] + bv[j]; *(f32x4*)(xr + 4 * lane + 256 * j) = o;
            u32x2 w; w.x = cvt_pk_bf16(o.x, o.y); w.y = cvt_pk_bf16(o.z, o.w); *(u32x2*)(xb + 4 * lane + 256 * j) = w; }
    }
}

DI void phase_fixup(const Ctx& c, int tid) {
    const float* cw = c.a.in[22] + (size_t)c.layer * 3 * NUP; const float* cb = c.a.in[23] + (size_t)c.layer * NUP;
    const float* halo = HALOp(c);
    bf16_t* act = Hp(c);
    for (int it = c.bid * 512 + tid; it < 128 * DFF; it += c.G * 512) {
        const int pm = it / DFF, col = it - pm * DFF;
        const float* h = halo + (size_t)pm * 4 * NUP;
        float cv[2][2];
#pragma unroll
        for (int bj = 0; bj < 2; ++bj) {
            const int oc = col + bj * DFF;
            const float v0 = h[oc], v1 = h[NUP + oc];
            float q2 = 0.f, q3 = 0.f;
            if ((pm & 7) != 0) { q2 = h[oc - 2 * (long)NUP]; q3 = h[oc - (long)NUP]; }
            const float w0 = cw[oc], w1 = cw[NUP + oc], w2 = cw[2 * NUP + oc], bb = cb[oc];
            cv[0][bj] = w0 * q2 + w1 * q3 + w2 * v0 + bb;
            cv[1][bj] = w0 * q3 + w1 * v0 + w2 * v1 + bb;
        }
#pragma unroll
        for (int r = 0; r < 2; ++r) { const float gg = cv[r][1]; act[(size_t)(pm * 256 + r) * DFF + ((col & ~31) + 16 * ((col >> 2) & 1) + 4 * ((col >> 3) & 3) + (col & 3))] = f2bf(cv[r][0] * gg * __builtin_amdgcn_rcpf(1.f + fast_exp(-gg))); }
    }
}

#define MFMA32(a, b, c) __builtin_amdgcn_mfma_f32_32x32x16_bf16((a), (b), (c), 0, 0, 0)
DI int crow(int r, int h) { return (r & 3) + 8 * (r >> 2) + 4 * h; }

DI void attn_prompt_item(const Ctx& c, LAS unsigned char* lds, int item, int tid) {
    asm volatile("" : "+v"(tid));
    const int hp = item & 1, kvh = (item >> 1) & 1, n = (item >> 2) & 15, b = item >> 6;
    const int wave = tid >> 6, lane = tid & 63, l31 = lane & 31, lh = lane >> 5;
    bf16_t* H = Hp(c);
    LAS bf16_t* Ks = (LAS bf16_t*)lds;
    LAS bf16_t* Vt = (LAS bf16_t*)(lds + 256 * 144);
    LAS bf16_t* Pb = (LAS bf16_t*)(lds + 256 * 144 + 64 * 528 + wave * 2560);
    const size_t row0 = (size_t)b * SEQ + (size_t)n * 128;
#pragma unroll
    for (int q = 0; q < 4; ++q) {
        const int ch = tid + 512 * q, kr = ch >> 3, part = ch & 7;
        u32x4 kv = (u32x4){0u, 0u, 0u, 0u}, vv = kv;
        if (n > 0 || kr >= 128) {
            const bf16_t* src = H + (row0 - 128 + kr) * LDH + kvh * 64 + part * 8;
            kv = *(const u32x4*)(src + KO); vv = *(const u32x4*)(src + VO);
        }
        *(LAS u32x4*)(Ks + kr * 72 + part * 8) = kv;
        const int d0 = part * 8;
        Vt[(d0 + 0) * 264 + kr] = (bf16_t)(vv.x & 0xffff); Vt[(d0 + 1) * 264 + kr] = (bf16_t)(vv.x >> 16);
        Vt[(d0 + 2) * 264 + kr] = (bf16_t)(vv.y & 0xffff); Vt[(d0 + 3) * 264 + kr] = (bf16_t)(vv.y >> 16);
        Vt[(d0 + 4) * 264 + kr] = (bf16_t)(vv.z & 0xffff); Vt[(d0 + 5) * 264 + kr] = (bf16_t)(vv.z >> 16);
        Vt[(d0 + 6) * 264 + kr] = (bf16_t)(vv.w & 0xffff); Vt[(d0 + 7) * 264 + kr] = (bf16_t)(vv.w >> 16);
    }
    __syncthreads();
    const int h = kvh * 4 + hp * 2 + (wave >> 2), a = wave & 3;
    const float slope = exp2f(-(float)(h + 1));
    const float sink = c.a.in[14][c.layer * 8 + h];
    bf16x8 qf[4];
    {
        const bf16_t* qp = H + (row0 + 32 * a + l31) * LDH + QO + h * 64 + 8 * lh;
#pragma unroll
        for (int ks = 0; ks < 4; ++ks) qf[ks] = *(const bf16x8*)(qp + 16 * ks);
    }
    f32x16 S[5];
#pragma unroll
    for (int kb = 0; kb < 5; ++kb) {
        f32x16 s;
#pragma unroll
        for (int r = 0; r < 16; ++r) s[r] = 0.f;
        const int j0 = 32 * a + 32 * kb;
#pragma unroll
        for (int ks = 0; ks < 4; ++ks) {
            const bf16x8 kf = *(const LAS bf16x8*)(Ks + (j0 + l31) * 72 + 16 * ks + 8 * lh);
            s = MFMA32(qf[ks], kf, s);
        }
        const int j = j0 + l31;
#pragma unroll
        for (int r = 0; r < 16; ++r) {
            const int i = 32 * a + crow(r, lh); const int dist = i + 128 - j;
            const bool ok = (dist >= 0) && (dist <= 128) && (n > 0 || j >= 128);
            s[r] = ok ? s[r] * 0.125f - slope * (float)dist : -1e30f;
        }
        S[kb] = s;
        asm volatile("" ::: "memory");
    }
    float drow[16];
#pragma unroll
    for (int r = 0; r < 16; ++r) {
        float mx = fmaxf(fmaxf(fmaxf(S[0][r], S[1][r]), fmaxf(S[2][r], S[3][r])), S[4][r]);
#pragma unroll
        for (int o = 1; o < 32; o <<= 1) mx = fmaxf(mx, __shfl_xor(mx, o));
        mx = fmaxf(mx, sink);
        float sm = 0.f;
#pragma unroll
        for (int kb = 0; kb < 5; ++kb) { const float p = fast_exp(S[kb][r] - mx); S[kb][r] = p; sm += p; }
#pragma unroll
        for (int o = 1; o < 32; o <<= 1) sm += __shfl_xor(sm, o);
        drow[r] = __builtin_amdgcn_rcpf(sm + fast_exp(sink - mx));
    }
    f32x16 O0, O1;
#pragma unroll
    for (int r = 0; r < 16; ++r) { O0[r] = 0.f; O1[r] = 0.f; }
#pragma unroll
    for (int kb = 0; kb < 5; ++kb) {
        const int j0 = 32 * a + 32 * kb;
#pragma unroll
        for (int r = 0; r < 16; ++r) Pb[crow(r, lh) * 40 + l31] = f2bf(S[kb][r]);
        asm volatile("s_waitcnt lgkmcnt(0)" ::: "memory");
#pragma unroll
        for (int k2 = 0; k2 < 2; ++k2) {
            const bf16x8 pf = *(const LAS bf16x8*)(Pb + l31 * 40 + 16 * k2 + 8 * lh);
            const bf16x8 v0 = *(const LAS bf16x8*)(Vt + l31 * 264 + j0 + 16 * k2 + 8 * lh);
            const bf16x8 v1 = *(const LAS bf16x8*)(Vt + (32 + l31) * 264 + j0 + 16 * k2 + 8 * lh);
            O0 = MFMA32(pf, v0, O0); O1 = MFMA32(pf, v1, O1);
        }
        asm volatile("s_waitcnt lgkmcnt(0)" ::: "memory");
    }
    {
        bf16_t* op = H + (row0 + 32 * a) * LDH + QO + h * 64 + l31;
#pragma unroll
        for (int r = 0; r < 16; ++r) { bf16_t* p = op + (size_t)crow(r, lh) * LDH; p[0] = f2bf(O0[r] * drow[r]); p[32] = f2bf(O1[r] * drow[r]); }
    }
    __syncthreads();
}

DI void attn_sample_item(const Ctx& c, LAS unsigned char* wl  , int item, int lane) {
    asm volatile("" : "+v"(lane));
    const int h = item & 7, b = item >> 3, kvh = h >> 2;
    bf16_t* H = Hp(c);
    LAS float* qs = (LAS float*)wl;
    LAS float* ps = (LAS float*)(wl + 2048);
    const size_t r0 = (size_t)MP + (size_t)b * 8;
    const float slope = exp2f(-(float)(h + 1));
    const float sink = c.a.in[14][c.layer * 8 + h];
#pragma unroll
    for (int i = 0; i < 8; ++i) qs[lane * 8 + i] = bf2f(H[(r0 + i) * LDH + QO + h * 64 + lane]);
    asm volatile("s_waitcnt lgkmcnt(0)" ::: "memory");
    const float* ck = c.a.in[2] + ((size_t)(c.layer * DB + b) * 128) * 128 + kvh * 64;
    const float* cv = c.a.in[3] + ((size_t)(c.layer * DB + b) * 128) * 128 + kvh * 64;
    float sc[3][8];
#pragma unroll
    for (int p = 0; p < 3; ++p) {
        const int j = lane + 64 * p;
        f32x4 kf[16];
        if (p < 2) {
            const float* kr = ck + (size_t)j * 128;
#pragma unroll
            for (int q4 = 0; q4 < 16; ++q4) kf[q4] = *(const f32x4*)(kr + 4 * q4);
        } else {
            const int jj = (j < 136) ? j - 128 : 0;
            const bf16_t* kr = H + (r0 + jj) * LDH + KO + kvh * 64;
#pragma unroll
            for (int q8 = 0; q8 < 8; ++q8) { const u32x4 w = *(const u32x4*)(kr + 8 * q8);
                kf[2 * q8] = (f32x4){bf_lo(w.x), bf_hi(w.x), bf_lo(w.y), bf_hi(w.y)}; kf[2 * q8 + 1] = (f32x4){bf_lo(w.z), bf_hi(w.z), bf_lo(w.w), bf_hi(w.w)}; }
        }
        float a8[8];
#pragma unroll
        for (int i = 0; i < 8; ++i) a8[i] = 0.f;
#pragma unroll
        for (int q4 = 0; q4 < 16; ++q4)
#pragma unroll
            for (int e = 0; e < 4; ++e) { const int d = 4 * q4 + e; const float kv = kf[q4][e];
                const f32x4 q0 = *(const LAS f32x4*)(qs + d * 8), q1 = *(const LAS f32x4*)(qs + d * 8 + 4);
                a8[0] += kv * q0[0]; a8[1] += kv * q0[1]; a8[2] += kv * q0[2]; a8[3] += kv * q0[3]; a8[4] += kv * q1[0]; a8[5] += kv * q1[1]; a8[6] += kv * q1[2]; a8[7] += kv * q1[3]; }
#pragma unroll
        for (int i = 0; i < 8; ++i) { const int dist = i + 128 - j; const bool ok = (j < 136) && dist >= 0 && dist <= 128; sc[p][i] = ok ? a8[i] * 0.125f - slope * (float)dist : -1e30f; }
        asm volatile("" ::: "memory");
    }
    float inv[8];
#pragma unroll
    for (int i = 0; i < 8; ++i) {
        const float mx = fmaxf(wave_max(fmaxf(fmaxf(sc[0][i], sc[1][i]), sc[2][i])), sink);
        float sm = 0.f;
#pragma unroll
        for (int p = 0; p < 3; ++p) { sc[p][i] = fast_exp(sc[p][i] - mx); sm += sc[p][i]; }
        inv[i] = 1.f / (wave_sum(sm) + fast_exp(sink - mx));
    }
#pragma unroll
    for (int p = 0; p < 3; ++p) { const int j = lane + 64 * p; if (j < 136) {
#pragma unroll
        for (int i = 0; i < 8; ++i) ps[j * 8 + i] = sc[p][i] * inv[i]; } }
    asm volatile("s_waitcnt lgkmcnt(0)" ::: "memory");
    float o[8];
#pragma unroll
    for (int i = 0; i < 8; ++i) o[i] = 0.f;
#pragma unroll 1
    for (int jb = 0; jb < 8; ++jb) {
        float vv[17];
#pragma unroll
        for (int u = 0; u < 17; ++u) { const int j = jb * 17 + u; vv[u] = j < 128 ? cv[(size_t)j * 128 + lane] : bf2f(H[(r0 + (j - 128)) * LDH + VO + kvh * 64 + lane]); }
#pragma unroll
        for (int u = 0; u < 17; ++u) { const int j = jb * 17 + u;
            const f32x4 p0 = *(const LAS f32x4*)(ps + j * 8), p1 = *(const LAS f32x4*)(ps + j * 8 + 4);
            o[0] += vv[u] * p0[0]; o[1] += vv[u] * p0[1]; o[2] += vv[u] * p0[2]; o[3] += vv[u] * p0[3]; o[4] += vv[u] * p1[0]; o[5] += vv[u] * p1[1]; o[6] += vv[u] * p1[2]; o[7] += vv[u] * p1[3]; }
    }
#pragma unroll
    for (int i = 0; i < 8; ++i) H[(r0 + i) * LDH + QO + h * 64 + lane] = f2bf(o[i]);
    asm volatile("s_waitcnt lgkmcnt(0)" ::: "memory");
}

DI void gmlp_prompt_item(const Ctx& c, LAS unsigned char* lds, int item, int tid) {
    asm volatile("" : "+v"(tid));
    const int wave = tid >> 6, lane = tid & 63, l31 = lane & 31, lh = lane >> 5;
    bf16_t* H = Hp(c);
    LAS bf16_t* VnT = (LAS bf16_t*)lds;
    const size_t row0 = (size_t)item * 128;
    const float* lg = c.a.in[9] + c.layer * 512; const float* lb = c.a.in[10] + c.layer * 512;
    float g8v[8], b8v[8];
#pragma unroll
    for (int e = 0; e < 8; ++e) { g8v[e] = lg[lane + 64 * e]; b8v[e] = lb[lane + 64 * e]; }
    bf16_t raw[16][8];
#pragma unroll
    for (int rr = 0; rr < 16; ++rr) { const bf16_t* src = H + (row0 + wave * 16 + rr) * LDH + GVO;
#pragma unroll
        for (int e = 0; e < 8; ++e) raw[rr][e] = src[lane + 64 * e]; }
#pragma unroll
    for (int rr = 0; rr < 16; ++rr) {
        const int s = wave * 16 + rr;
        float v[8]; float sm = 0.f;
#pragma unroll
        for (int e = 0; e < 8; ++e) { v[e] = bf2f(raw[rr][e]); sm += v[e]; }
        const float mean = wave_sum(sm) * (1.f / 512.f); float s2 = 0.f;
#pragma unroll
        for (int e = 0; e < 8; ++e) { v[e] -= mean; s2 += v[e] * v[e]; }
        const float rstd = 1.f / sqrtf(wave_sum(s2) * (1.f / 512.f) + LN_EPS);
#pragma unroll
        for (int e = 0; e < 8; ++e) VnT[(lane + 64 * e) * 136 + s] = f2bf(v[e] * rstd * g8v[e] + b8v[e]);
    }
    __syncthreads();
    const int g = wave >> 1, ch = wave & 1;
    const float* Ws = c.a.in[11] + ((size_t)(c.layer * 4 + g) * 128) * 128;
    f32x16 acc[4][2];
#pragma unroll
    for (int tb = 0; tb < 4; ++tb)
#pragma unroll
        for (int cb = 0; cb < 2; ++cb)
#pragma unroll
            for (int r = 0; r < 16; ++r) acc[tb][cb][r] = 0.f;
#pragma unroll
    for (int ks = 0; ks < 8; ++ks) {
        bf16x8 bfr[2];
#pragma unroll
        for (int cb = 0; cb < 2; ++cb) bfr[cb] = *(const LAS bf16x8*)(VnT + (g * 128 + ch * 64 + 32 * cb + l31) * 136 + 16 * ks + 8 * lh);
#pragma unroll
        for (int tb = 0; tb < 4; ++tb) {
            if (ks <= 2 * tb + 1) {
                const int t = 32 * tb + l31, s0 = 16 * ks + 8 * lh;
                const f32x4 w0 = *(const f32x4*)(Ws + (size_t)t * 128 + s0), w1 = *(const f32x4*)(Ws + (size_t)t * 128 + s0 + 4);
                u32x4 pk;
                pk.x = cvt_pk_bf16(s0 + 0 <= t ? w0[0] : 0.f, s0 + 1 <= t ? w0[1] : 0.f); pk.y = cvt_pk_bf16(s0 + 2 <= t ? w0[2] : 0.f, s0 + 3 <= t ? w0[3] : 0.f);
                pk.z = cvt_pk_bf16(s0 + 4 <= t ? w1[0] : 0.f, s0 + 5 <= t ? w1[1] : 0.f); pk.w = cvt_pk_bf16(s0 + 6 <= t ? w1[2] : 0.f, s0 + 7 <= t ? w1[3] : 0.f);
                const bf16x8 af = __builtin_bit_cast(bf16x8, pk);
#pragma unroll
                for (int cb = 0; cb < 2; ++cb) acc[tb][cb] = MFMA32(af, bfr[cb], acc[tb][cb]);
            }
        }
    }
    const float* bs = c.a.in[12] + (size_t)(c.layer * 4 + g) * 128;
#pragma unroll
    for (int tb = 0; tb < 4; ++tb)
#pragma unroll
        for (int r = 0; r < 16; ++r) {
            const int t = 32 * tb + crow(r, lh); const float bt = bs[t];
            bf16_t* gp = H + (row0 + t) * LDH + GUO + g * 128 + ch * 64 + l31;
#pragma unroll
            for (int cb = 0; cb < 2; ++cb) gp[32 * cb] = f2bf(bf2f(gp[32 * cb]) * (acc[tb][cb][r] + bt));
        }
    __syncthreads();
}

DI void gmlp_sample_item(const Ctx& c, int b, int lane) {
    asm volatile("" : "+v"(lane));
    bf16_t* H = Hp(c);
    const size_t r0 = (size_t)MP + (size_t)b * 8;
    const float* lg = c.a.in[9] + c.layer * 512; const float* lb = c.a.in[10] + c.layer * 512;
    float vn[8][8];
#pragma unroll
    for (int s = 0; s < 8; ++s) {
        const bf16_t* src = H + (r0 + s) * LDH + GVO;
        float sm = 0.f;
#pragma unroll
        for (int e = 0; e < 8; ++e) { vn[s][e] = bf2f(src[lane + 64 * e]); sm += vn[s][e]; }
        const float mean = wave_sum(sm) * (1.f / 512.f); float s2 = 0.f;
#pragma unroll
        for (int e = 0; e < 8; ++e) { vn[s][e] -= mean; s2 += vn[s][e] * vn[s][e]; }
        const float rstd = 1.f / sqrtf(wave_sum(s2) * (1.f / 512.f) + LN_EPS);
        float* go = c.out + O_GVS + ((size_t)(c.layer * DB + b) * 8 + s) * 512;
#pragma unroll
        for (int e = 0; e < 8; ++e) { vn[s][e] = vn[s][e] * rstd * lg[lane + 64 * e] + lb[lane + 64 * e]; go[lane + 64 * e] = vn[s][e]; }
    }
#pragma unroll
    for (int t = 0; t < 8; ++t) {
        bf16_t* gp = H + (r0 + t) * LDH + GUO;
#pragma unroll
        for (int e = 0; e < 8; ++e) {
            const int g = e >> 1;
            const float* Ws = c.a.in[11] + ((size_t)(c.layer * 4 + g) * 128 + t) * 128;
            float a = c.a.in[12][(c.layer * 4 + g) * 128 + t];
#pragma unroll
            for (int s = 0; s < 8; ++s) if (s <= t) a += Ws[s] * vn[s][e];
            gp[lane + 64 * e] = f2bf(bf2f(gp[lane + 64 * e]) * a);
        }
    }
}

DI void phase_mixer(const Ctx& c, LAS unsigned char* lds, int tid) {
    const int wave = tid >> 6, lane = tid & 63;
    for (int it = c.bid; it < 1024; it += c.G) attn_prompt_item(c, lds, it, tid);
    for (int it = c.bid; it < 256; it += c.G) gmlp_prompt_item(c, lds, it, tid);
    __syncthreads();
    for (int it = c.bid * 8 + wave; it < 1024 + 128; it += c.G * 8) {
        if (it < 1024) attn_sample_item(c, lds + wave * 8192, it, lane);
        else gmlp_sample_item(c, it - 1024, lane);
    }
    bf16_t* H = Hp(c);
    const int gt = c.bid * 512 + tid, GT = c.G * 512;
    {
        const int c0 = (gt & 63) * 8;
        const float* mw = c.a.in[13] + (size_t)c.layer * 3 * 512 + c0;
        float w0[8], w1[8], w2[8];
#pragma unroll
        for (int e = 0; e < 8; ++e) { w0[e] = mw[e]; w1[e] = mw[512 + e]; w2[e] = mw[1024 + e]; }
#pragma unroll 1
        for (int run = gt >> 6; run < MT / 8; run += GT >> 6) {
            const int row0 = run * 8; const bool samp = row0 >= MP;
            int t0, b; if (!samp) { t0 = row0 & (SEQ - 1); b = row0 >> 11; } else { t0 = 0; b = (row0 - MP) >> 3; }
            float z0[8], z1[8];
            if (samp) { const float* st = c.a.in[4] + ((size_t)(c.layer * DB + b) * 2) * 512 + c0;
#pragma unroll
                for (int e = 0; e < 8; ++e) { z0[e] = st[e]; z1[e] = st[512 + e]; } }
            else if (t0 == 0) {
#pragma unroll
                for (int e = 0; e < 8; ++e) { z0[e] = 0.f; z1[e] = 0.f; } }
            else { const bf16_t* hp = H + (size_t)(row0 - 2) * LDH;
                const u32x4 a0 = *(const u32x4*)(hp + SCO + c0), d0 = *(const u32x4*)(hp + SHO + c0), a1 = *(const u32x4*)(hp + LDH + SCO + c0), d1 = *(const u32x4*)(hp + LDH + SHO + c0);
                z0[0] = bf_lo(a0.x) * bf_lo(d0.x); z0[1] = bf_hi(a0.x) * bf_hi(d0.x); z0[2] = bf_lo(a0.y) * bf_lo(d0.y); z0[3] = bf_hi(a0.y) * bf_hi(d0.y);
                z0[4] = bf_lo(a0.z) * bf_lo(d0.z); z0[5] = bf_hi(a0.z) * bf_hi(d0.z); z0[6] = bf_lo(a0.w) * bf_lo(d0.w); z0[7] = bf_hi(a0.w) * bf_hi(d0.w);
                z1[0] = bf_lo(a1.x) * bf_lo(d1.x); z1[1] = bf_hi(a1.x) * bf_hi(d1.x); z1[2] = bf_lo(a1.y) * bf_lo(d1.y); z1[3] = bf_hi(a1.y) * bf_hi(d1.y);
                z1[4] = bf_lo(a1.z) * bf_lo(d1.z); z1[5] = bf_hi(a1.z) * bf_hi(d1.z); z1[6] = bf_lo(a1.w) * bf_lo(d1.w); z1[7] = bf_hi(a1.w) * bf_hi(d1.w); }
            u32x4 av[8], dv[8], sv[8];
#pragma unroll
            for (int r = 0; r < 8; ++r) { const bf16_t* hr = H + (size_t)(row0 + r) * LDH; av[r] = *(const u32x4*)(hr + SCO + c0); dv[r] = *(const u32x4*)(hr + SHO + c0); sv[r] = *(const u32x4*)(hr + SBO + c0); }
#pragma unroll
            for (int r = 0; r < 8; ++r) {
                float z2[8];
                z2[0] = bf_lo(av[r].x) * bf_lo(dv[r].x); z2[1] = bf_hi(av[r].x) * bf_hi(dv[r].x); z2[2] = bf_lo(av[r].y) * bf_lo(dv[r].y); z2[3] = bf_hi(av[r].y) * bf_hi(dv[r].y);
                z2[4] = bf_lo(av[r].z) * bf_lo(dv[r].z); z2[5] = bf_hi(av[r].z) * bf_hi(dv[r].z); z2[6] = bf_lo(av[r].w) * bf_lo(dv[r].w); z2[7] = bf_hi(av[r].w) * bf_hi(dv[r].w);
                const float sbf[8] = {bf_lo(sv[r].x), bf_hi(sv[r].x), bf_lo(sv[r].y), bf_hi(sv[r].y), bf_lo(sv[r].z), bf_hi(sv[r].z), bf_lo(sv[r].w), bf_hi(sv[r].w)};
                float o[8];
#pragma unroll
                for (int e = 0; e < 8; ++e) o[e] = sbf[e] * (w0[e] * z0[e] + w1[e] * z1[e] + w2[e] * z2[e]);
                u32x4 w; w.x = cvt_pk_bf16(o[0], o[1]); w.y = cvt_pk_bf16(o[2], o[3]); w.z = cvt_pk_bf16(o[4], o[5]); w.w = cvt_pk_bf16(o[6], o[7]);
                *(u32x4*)(H + (size_t)(row0 + r) * LDH + SBO + c0) = w;
                const int t = t0 + r; const int tl = samp ? DS : SEQ;
                if (t >= tl - 2) {
                    float* dst = c.out + (samp ? O_MCS + ((size_t)(c.layer * DB + b) * 2 + (t - (tl - 2))) * 512 : O_MCP + ((size_t)(c.layer * NB + b) * 2 + (t - (tl - 2))) * 512) + c0;
                    *(f32x4*)dst = (f32x4){z2[0], z2[1], z2[2], z2[3]}; *(f32x4*)(dst + 4) = (f32x4){z2[4], z2[5], z2[6], z2[7]};
                }
#pragma unroll
                for (int e = 0; e < 8; ++e) { z0[e] = z1[e]; z1[e] = z2[e]; }
            }
        }
    }
}

DI void phase_dbg(const Ctx& c, int tid) {
    const bf16_t* H = Hp(c);
#pragma unroll 1
    for (int it = c.bid * 512 + tid; it < MT * DM; it += c.G * 512) { const int row = it >> 10, col = it & 1023; c.out[it] = bf2f(H[(size_t)row * LDH + MGO + col]); }
}

DI void phase_windows(const Ctx& c, int gt, int GT) {
    bf16_t* H = Hp(c);
#pragma unroll 1
    for (int it = gt; it < NB * 128 * 32; it += GT) {
        const int cc = (it & 31) * 4, j = (it >> 5) & 127, b = it >> 12;
        const bf16_t* hr = H + ((size_t)b * SEQ + 1920 + j) * LDH;
        const u32x2 kq = *(const u32x2*)(hr + KO + cc), vq = *(const u32x2*)(hr + VO + cc);
        *(f32x4*)(c.out + O_KP + (size_t)c.layer * NB * 16384 + (size_t)it * 4) = (f32x4){bf_lo(kq.x), bf_hi(kq.x), bf_lo(kq.y), bf_hi(kq.y)};
        *(f32x4*)(c.out + O_VP + (size_t)c.layer * NB * 16384 + (size_t)it * 4) = (f32x4){bf_lo(vq.x), bf_hi(vq.x), bf_lo(vq.y), bf_hi(vq.y)};
    }
#pragma unroll 1
    for (int it = gt; it < DB * 128 * 32; it += GT) {
        const int cc = (it & 31) * 4, j = (it >> 5) & 127, b = it >> 12;
        f32x4 kv, vv;
        if (j < 120) { const size_t o = ((size_t)(c.layer * DB + b) * 128 + j + 8) * 128 + cc; kv = *(const f32x4*)(c.a.in[2] + o); vv = *(const f32x4*)(c.a.in[3] + o); }
        else { const bf16_t* hr = H + ((size_t)MP + b * 8 + (j - 120)) * LDH; const u32x2 kq = *(const u32x2*)(hr + KO + cc), vq = *(const u32x2*)(hr + VO + cc);
            kv = (f32x4){bf_lo(kq.x), bf_hi(kq.x), bf_lo(kq.y), bf_hi(kq.y)}; vv = (f32x4){bf_lo(vq.x), bf_hi(vq.x), bf_lo(vq.y), bf_hi(vq.y)}; }
        *(f32x4*)(c.out + O_KS + (size_t)c.layer * DB * 16384 + (size_t)it * 4) = kv;
        *(f32x4*)(c.out + O_VS + (size_t)c.layer * DB * 16384 + (size_t)it * 4) = vv;
    }
}
#define XB_TMO      128
#define XB_XCNT(j)  (256  + 64 * (j))
#define XB_XSUB(j)  (1280 + 64 * (j))
#define XB_XGEN(j)  (2304 + 64 * (j))
#define XB_TOP      3328
#define XB_TOPGEN   3392
#define XCD_BAR_WORDS 3456
#define XB_SPIN_CAP (1u << 18)
DI unsigned xb_ld(unsigned* p)              { return __hip_atomic_load(p, __ATOMIC_RELAXED, __HIP_MEMORY_SCOPE_AGENT); }
DI unsigned xb_add(unsigned* p, unsigned v) { return __hip_atomic_fetch_add(p, v, __ATOMIC_RELAXED, __HIP_MEMORY_SCOPE_AGENT); }
DI unsigned xb_xcc_id() { return (unsigned)__builtin_amdgcn_s_getreg((3 << 11) | 20) & 0xFu; }
#define XB_SPIN(cond, bar) do { unsigned _sp = 0; while (cond) { __builtin_amdgcn_s_sleep(1); \
    if ((++_sp & 255u) == 0u) { if (xb_ld(&(bar)[XB_TMO])) break; if (_sp > XB_SPIN_CAP) { atomicAdd(&(bar)[XB_TMO], 1u); break; } } } } while (0)
struct XcdBarrier { unsigned* bar; unsigned x; volatile LAS unsigned* st; };
DI XcdBarrier xcd_barrier_post(unsigned* bar, volatile LAS unsigned* st) {
    XcdBarrier b; b.bar = bar; b.x = xb_xcc_id(); b.st = st;
    if (threadIdx.x == 0) (void)xb_add(&bar[XB_XCNT(b.x)], 1u);
    return b;
}
DI void xcd_barrier_complete(unsigned* bar, unsigned x, unsigned& nloc, unsigned& nx) {
    const unsigned G = gridDim.x * gridDim.y * gridDim.z;
    unsigned sum, cnt, mine, sp = 0u;
    for (;;) {
        sum = 0u; cnt = 0u; mine = 0u;
#pragma unroll
        for (unsigned j = 0; j < 16; ++j) { const unsigned c = xb_ld(&bar[XB_XCNT(j)]); sum += c; cnt += (c > 0u) ? 1u : 0u; mine = (j == x) ? c : mine; }
        if (sum == G) break;
        __builtin_amdgcn_s_sleep(1);
        if ((++sp & 255u) == 0u) { if (xb_ld(&bar[XB_TMO])) break; if (sp > XB_SPIN_CAP) { atomicAdd(&bar[XB_TMO], 1u); break; } }
    }
    nloc = mine > 0u ? mine : 1u; nx = cnt > 0u ? cnt : 1u;
}
DI void xcd_barrier(const XcdBarrier& b, bool leader) {
    asm volatile("s_waitcnt vmcnt(0)" ::: "memory");
    __syncthreads();
    if (leader) {
        unsigned* bar = b.bar;
        __builtin_amdgcn_s_waitcnt(0);
        unsigned nloc = b.st[0], nx = b.st[1];
        if (nloc == 0u) { xcd_barrier_complete(bar, b.x, nloc, nx); b.st[0] = nloc; b.st[1] = nx; }
        const unsigned old = xb_add(&bar[XB_XSUB(b.x)], 1u);
        const unsigned gen = old / nloc;
        if (old + 1u == (gen + 1u) * nloc) {
            __builtin_amdgcn_fence(__ATOMIC_RELEASE, "agent");
            asm volatile("s_waitcnt vmcnt(0)" ::: "memory");
            const unsigned og = xb_add(&bar[XB_TOP], 1u);
            const unsigned tg = og / nx;
            if (og + 1u == (tg + 1u) * nx) xb_add(&bar[XB_TOPGEN], 1u);
            else XB_SPIN(xb_ld(&bar[XB_TOPGEN]) == tg, bar);
            __builtin_amdgcn_fence(__ATOMIC_ACQUIRE, "agent");
            xb_add(&bar[XB_XGEN(b.x)], 1u);
            asm volatile("s_waitcnt vmcnt(0)" ::: "memory");
        } else {
            XB_SPIN(xb_ld(&bar[XB_XGEN(b.x)]) == gen, bar);
            __builtin_amdgcn_fence(__ATOMIC_ACQUIRE, "agent");
            asm volatile("s_waitcnt vmcnt(0)" ::: "memory");
        }
    }
    __syncthreads();
}
#ifndef REPMASK
#define REPMASK 0
#endif
DI int lane_id_fresh() { int l; asm volatile("v_mbcnt_lo_u32_b32 %0, -1, 0\n\tv_mbcnt_hi_u32_b32 %0, -1, %0" : "=v"(l)); return l; }
__global__ void __launch_bounds__(512, 2) fwd_kernel(Args args) {
    extern __shared__ __attribute__((aligned(16))) unsigned char smem[];
    LAS unsigned char* lds = (LAS unsigned char*)smem;
    cg::grid_group grid = cg::this_grid();
    int layer_s = 0;
    volatile LAS unsigned* xst = (volatile LAS unsigned*)(lds + LDS_BYTES - 64);
    if (threadIdx.x < 16) xst[threadIdx.x] = 0u;
    __syncthreads();
    const int wave_s = __builtin_amdgcn_readfirstlane((int)threadIdx.x >> 6);
    const XcdBarrier xbar = xcd_barrier_post((unsigned*)args.ws, xst);
#define SEAM_CG() do { asm volatile("s_waitcnt vmcnt(0) lgkmcnt(0)" ::: "memory");     \
        grid.sync(); \
        asm volatile("s_waitcnt vmcnt(0)" ::: "memory");                \
        __syncthreads(); } while (0)
#define SEAM() xcd_barrier(xbar, wave_s == 0 && lane_id_fresh() == 0)
#define RUN(...) { int tid = wave_s * 64 + lane_id_fresh(); \
        int g_ = (int)gridDim.x, b_ = (int)blockIdx.x, l_ = layer_s; unsigned char* w_ = args.ws; float* o_ = args.out; \
        asm volatile("" : "+s"(g_), "+s"(b_), "+s"(l_), "+s"(w_), "+s"(o_));     \
        const Ctx c{args, w_, o_, g_, b_, l_}; __VA_ARGS__; }
    RUN(phase_prologue(c, lds, tid)); SEAM_CG();
    for (int l = 0; l < 2; ++l) {
        layer_s = l;
        RUN({ PhIn p{c}; g8::run(lds, p, tid); }); SEAM();
        RUN(phase_mixer(c, lds, tid)); SEAM();
        RUN({ PhMerge p{c}; g8::run(lds, p, tid);
              { const int full = 528 / c.G, tail = 528 - full * c.G, busy = (2 * tail <= c.G && tail <= 16) ? 2 * tail : tail;
                if (c.bid >= busy) { phase_windows(c, (c.bid - busy) * 512 + tid, (c.G - busy) * 512);
                    if (l == 0) convert_layer_weights(c, 0, (LAS float*)(lds + (tid >> 6) * 16384), (c.bid - busy) * 8 + (tid >> 6), (c.G - busy) * 8, tid & 63, CW_A, CW_B); } } });
        SEAM();
        RUN({ PhRes p{c, 0}; g8::run(lds, p, tid);
              if (l == 0) { const int full = 528 / c.G, tail = 528 - full * c.G, busy = (2 * tail <= c.G && tail <= 16) ? 2 * tail : tail;
                  const int vcu = (c.G & 7) == 0 ? (c.bid & 7) * (c.G >> 3) + (c.bid >> 3) : c.bid;
                  if (vcu >= busy) convert_layer_weights(c, 0, (LAS float*)(lds + (tid >> 6) * 16384), (vcu - busy) * 8 + (tid >> 6), (c.G - busy) * 8, tid & 63, CW_B, CW_ALL); } }); SEAM();
        RUN({ PhUp p{c}; g8::run(lds, p, tid);
              if (l == 0) {
                  const int tiles = 132 * 22, tail = tiles % c.G, idle = tail ? c.G - tail : c.G, me = tail ? c.bid - tail : c.bid;
                  if (me >= 0) convert_layer_weights(c, 1, (LAS float*)(lds + (tid >> 6) * 16384), me * 8 + (tid >> 6), idle * 8, tid & 63);
              } }); SEAM();
        RUN(phase_fixup(c, tid)); SEAM();
        RUN({ PhRes p{c, 1}; g8::run(lds, p, tid); }); SEAM();
    }
}

extern "C" void kernel_launch(void* const* d_in, const int* in_sizes, int n_in, void* d_out, int out_size, void* d_ws, size_t ws_size, hipStream_t stream) {
    static int grid = 0;
    if (grid == 0) {
        int dev = 0, cus = 0, per_cu = 0;
        if (n_in != 27 || (size_t)out_size != O_END || ws_size < WS_END) { fprintf(stderr, "kernel_launch: unexpected shapes (n_in %d out %d ws %zu)\n", n_in, out_size, ws_size); grid = -1; return; }
        (void)hipGetDevice(&dev);
        (void)hipDeviceGetAttribute(&cus, hipDeviceAttributeMultiprocessorCount, dev);
        (void)hipFuncSetAttribute((const void*)fwd_kernel, hipFuncAttributeMaxDynamicSharedMemorySize, LDS_BYTES);
        (void)hipOccupancyMaxActiveBlocksPerMultiprocessor(&per_cu, (const void*)fwd_kernel, 512, LDS_BYTES);
        if (per_cu < 1) { fprintf(stderr, "kernel_launch: occupancy query says %d blocks per CU\n", per_cu); per_cu = 1; }
        grid = cus < 256 ? cus : 256;
    }
    if (grid < 0) return;
    if (hipMemsetAsync(d_ws, 0, CTL_ZERO_BYTES, stream) != hipSuccess) { fprintf(stderr, "kernel_launch: memset failed\n"); return; }
    Args a{};
    for (int i = 0; i < 27; ++i) a.in[i] = (const float*)d_in[i];
    a.out = (float*)d_out; a.ws = (unsigned char*)d_ws;
    void* kargs[] = {&a};
    hipError_t e = hipLaunchCooperativeKernel((const void*)fwd_kernel, dim3(grid), dim3(512), kargs, LDS_BYTES, stream);
    if (e != hipSuccess) fprintf(stderr, "cooperative launch failed: %s (grid %d)\n", hipGetErrorString(e), grid);
}
```

```cpp
#include <hip/hip_runtime.h>
#include <hip/hip_cooperative_groups.h>
#include <cstdio>
#include <cstdint>
namespace cg = cooperative_groups;

#define LAS __attribute__((address_space(3)))
#define DI __device__ __forceinline__
typedef unsigned short bf16_t;
typedef short bf16x8 __attribute__((ext_vector_type(8)));
typedef float f32x4 __attribute__((ext_vector_type(4)));
typedef float f32x16 __attribute__((ext_vector_type(16)));
typedef unsigned u32x4 __attribute__((ext_vector_type(4)));
typedef unsigned u32x2 __attribute__((ext_vector_type(2)));

constexpr int MP = 32768, MS = 1024, MT = MP + MS, DM = 1024, NIN = 3328, NGATE = 3072, DFF = 2816, NUP = 5632;
constexpr int SEQ = 2048, NB = 16, DB = 128, DS = 8;
constexpr int QO = 0, KO = 512, VO = 640, GUO = 768, GVO = 1280, SBO = 1792, SCO = 2304, SHO = 2816, MGO = 2304;
constexpr int LDH = 3328;
constexpr float ALPHA = 1.41421356237309515f;
constexpr float LN_EPS = 1e-5f;
constexpr size_t W_IN = 0, W_G = W_IN + (size_t)NIN * DM, W_PA = W_G + (size_t)NGATE * DM, W_PG = W_PA + 512 * 1024, W_PC = W_PG + 512 * 1024,
                 W_O = W_PC + 512 * 1024, W_UP = W_O + 1024 * 1024, W_DN = W_UP + (size_t)NUP * DM, W_LAYER = W_DN + (size_t)DM * DFF;
constexpr size_t MiB = 1u << 20;
constexpr size_t WS_WT = 1 * MiB, WS_XB = 69 * MiB, WS_H = 135 * MiB, WS_GS = 350 * MiB, WS_HALO = 478 * MiB, WS_XBUF = 490 * MiB, WS_PART = 496 * MiB, WS_END = 500 * MiB;
constexpr size_t WS_CNT = 16384, CTL_ZERO_BYTES = 262144;
constexpr size_t XBUF_INST = (size_t)132 * 256 * 4 * 8;
constexpr size_t WS_PFLAG = WS_CNT + 4 * 132 * 256;
static_assert(WS_PFLAG + 6 * 16 * 256 <= CTL_ZERO_BYTES && WS_PART + (size_t)16 * 512 * 512 <= WS_END, "ws map 4");
static_assert(WS_CNT + 4 * 132 * 256 <= CTL_ZERO_BYTES && WS_XBUF + 4 * XBUF_INST <= WS_END, "ws map 3");
constexpr int XL_OFF = 131072;
static_assert(WS_WT + 2 * W_LAYER * 2 <= WS_XB && WS_XB + (size_t)MT * DM * 2 <= WS_H && WS_H + (size_t)MT * LDH * 2 <= WS_GS, "ws map");
static_assert(WS_GS + (size_t)MT * NGATE <= WS_HALO && WS_HALO + (size_t)132 * 4 * NUP * 4 <= WS_END, "ws map 2");
constexpr size_t O_Y = 0, O_KP = (size_t)MT * DM, O_VP = O_KP + 524288, O_MCP = O_VP + 524288, O_FCP = O_MCP + 32768, O_KS = O_FCP + 360448,
                 O_VS = O_KS + 4194304, O_MCS = O_VS + 4194304, O_FCS = O_MCS + 262144, O_GVS = O_FCS + 2883584, O_END = O_GVS + 1048576;
constexpr int LDS_BYTES = 147456;
constexpr int HL_OFF = 131072;

typedef float f32x2_t __attribute__((ext_vector_type(2)));
typedef __bf16 bf16x2_t __attribute__((ext_vector_type(2)));
DI unsigned cvt_pk_bf16(float lo, float hi) { const f32x2_t v = {lo, hi}; return __builtin_bit_cast(unsigned, __builtin_convertvector(v, bf16x2_t)); }
DI float bf_lo(unsigned u) { return __uint_as_float(u << 16); }
DI float bf_hi(unsigned u) { return __uint_as_float(u & 0xffff0000u); }
DI float bf2f(bf16_t h) { return __uint_as_float((unsigned)h << 16); }
DI bf16_t f2bf(float f) { return (bf16_t)(cvt_pk_bf16(f, 0.f) & 0xffffu); }
DI float fast_exp(float x) { return __builtin_amdgcn_exp2f(x * 1.44269504089f); }
DI float sigmoidf(float x) { x = fminf(fmaxf(x, -30.f), 30.f); return __builtin_amdgcn_rcpf(1.f + fast_exp(-x)); }
DI float wave_sum(float v) {
#pragma unroll
    for (int o = 1; o < 64; o <<= 1) v += __shfl_xor(v, o);
    return v;
}
DI float wave_max(float v) {
#pragma unroll
    for (int o = 1; o < 64; o <<= 1) v = fmaxf(v, __shfl_xor(v, o));
    return v;
}
template <int CTRL> DI float dppz(float src) {
    return __builtin_bit_cast(float, __builtin_amdgcn_update_dpp(0, __builtin_bit_cast(int, src), CTRL, 0xf, 0xf, true));
}
template <int CTRL> DI f32x4 dppz4(f32x4 s) { f32x4 r; r.x = dppz<CTRL>(s.x); r.y = dppz<CTRL>(s.y); r.z = dppz<CTRL>(s.z); r.w = dppz<CTRL>(s.w); return r; }
template <int CTRL> DI float dppo(float old, float src) {
    return __builtin_bit_cast(float, __builtin_amdgcn_update_dpp(__builtin_bit_cast(int, old), __builtin_bit_cast(int, src), CTRL, 0xf, 0xf, false));
}
template <int CTRL> DI f32x4 dppo4(f32x4 o, f32x4 s) { f32x4 r; r.x = dppo<CTRL>(o.x, s.x); r.y = dppo<CTRL>(o.y, s.y); r.z = dppo<CTRL>(o.z, s.z); r.w = dppo<CTRL>(o.w, s.w); return r; }
DI f32x4 sel4(bool c, f32x4 a, f32x4 b) { f32x4 r; r.x = c ? a.x : b.x; r.y = c ? a.y : b.y; r.z = c ? a.z : b.z; r.w = c ? a.w : b.w; return r; }

namespace g8 {
constexpr int BM = 256, BK = 64, HALF = 128, HTB = HALF * BK * 2, RING = 8 * HTB;
DI int lds_byte(int r, int c) { const int st = (r >> 4) * 2 + (c >> 5), rr = r & 15, cc = c & 31, ob = rr * 64 + cc * 2; return st * 1024 + (ob ^ (((ob >> 9) & 1) << 5)); }
DI void stage_rc(int b, int& R, int& C) { const int st = b / 1024, sb = b % 1024, swz = sb ^ (((sb >> 9) & 1) << 5); R = (st >> 1) * 16 + swz / 64; C = (st & 1) * 32 + (swz % 64) / 2; }
DI int perm32(int rho) { const int n = rho >> 4, i = rho & 15; return 8 * (i >> 2) + 4 * n + (i & 3); }

struct UnitD {
    const char* A; const char* B;
    unsigned lda, ldb;
    int nt;
    int pm, pn, sub;
    bool permA;
    int split, slot;
    bool zero, perm;
};
DI void tile_of(int L, int nM, int nN, int& pm, int& pn) {
    const int nwg = nM * nN; int wgid = L;
    { const int q = nwg / 8, r = nwg % 8, xcd = wgid % 8, off = wgid / 8; wgid = (xcd < r ? xcd * (q + 1) : r * (q + 1) + (xcd - r) * q) + off; }
    const int nig = 8 * nN, gid = wgid / nig, fm = gid * 8, gsz = (nM - fm) < 8 ? (nM - fm) : 8;
    pm = fm + ((wgid % nig) % gsz); pn = (wgid % nig) / gsz;
}

template <class P>
DI void run(LAS unsigned char* lds, const P& ph, int tid_in) {
    int tid = tid_in; asm volatile("" : "+v"(tid));
    const int wid = __builtin_amdgcn_readfirstlane(tid >> 6), lane = tid & 63, wr = wid >> 2, wc = wid & 3, fr = lane & 15, fq = lane >> 4;
    int R, C; stage_rc(tid * 16, R, C);
    const int Rp = (R & ~31) + perm32(R & 31);
    const int Ra = (R & ~63) + 4 * (R & 15) + ((R & 63) >> 4);
    const unsigned C2 = (unsigned)C * 2u;
    const unsigned ldsw = (unsigned)wid * 1024u;
    const int aoff = lds_byte(wr * 64 + fr, fq * 8), boff = lds_byte(wc * 32 + fr, fq * 8);
#define G8_SA(b, h) (((b) * 2 + (h)) * HTB)
#define G8_SB(b, h) ((4 + (b) * 2 + (h)) * HTB)
#define G8_STG(bufoff, gp, vo, ld) do { \
        __builtin_amdgcn_global_load_lds((const unsigned*)((gp) + (vo)), (LAS unsigned*)(lds + (bufoff) + ldsw), 16, 0, 0); \
        __builtin_amdgcn_global_load_lds((const unsigned*)((gp) + ((vo) + 64u * (ld))), (LAS unsigned*)(lds + (bufoff) + ldsw + 8192), 16, 0, 0); } while (0)
#define G8_LDA(dst, b, h) do { _Pragma("unroll") for (int m = 0; m < 4; ++m) _Pragma("unroll") for (int k = 0; k < 2; ++k) dst[m][k] = *(const LAS bf16x8*)(lds + G8_SA(b, h) + aoff + m * 2048 + k * 1024); } while (0)
#define G8_LDB(dst, b, h) do { _Pragma("unroll") for (int n = 0; n < 2; ++n) _Pragma("unroll") for (int k = 0; k < 2; ++k) dst[n][k] = *(const LAS bf16x8*)(lds + G8_SB(b, h) + boff + n * 2048 + k * 1024); } while (0)
#define G8_MMA(ai, bj, At, Bt) do { __builtin_amdgcn_s_setprio(1); _Pragma("unroll") for (int m = 0; m < 4; ++m) _Pragma("unroll") for (int n = 0; n < 2; ++n) _Pragma("unroll") for (int k = 0; k < 2; ++k) \
        acc[ai][bj][m][n] = __builtin_amdgcn_mfma_f32_16x16x32_bf16(Bt[n][k], At[m][k], acc[ai][bj][m][n], 0, 0, 0); __builtin_amdgcn_s_setprio(0); } while (0)
#define G8_WAIT_V(n) asm volatile("s_waitcnt vmcnt(" #n ")" ::: "memory")
#define G8_WAIT_L(n) asm volatile("s_waitcnt lgkmcnt(" #n ")" ::: "memory")
#define G8_BAR __builtin_amdgcn_s_barrier()
#define G8_SCHED __builtin_amdgcn_sched_barrier(0)
    UnitD cur, nxt; int ui = 0;
    if (!ph.get(0, cur)) return;
    f32x4 acc[2][2][4][2];
#pragma unroll
    for (int a = 0; a < 2; ++a)
#pragma unroll
        for (int b = 0; b < 2; ++b)
#pragma unroll
            for (int m = 0; m < 4; ++m)
#pragma unroll
                for (int n = 0; n < 2; ++n) acc[a][b][m][n] = (f32x4){0.f, 0.f, 0.f, 0.f};
    bf16x8 At[4][2], B0[2][2], B1[2][2];
    const char* cA = cur.A; const char* cB = cur.B;
    unsigned lda = cur.lda, ldb = cur.ldb;
    unsigned vA = (unsigned)(cur.permA ? Ra : R) * lda + C2, vB = (unsigned)(cur.perm ? Rp : R) * ldb + C2;
    {
        const unsigned hA = 128u * lda, hB = 128u * ldb;
        G8_STG(G8_SB(0, 0), cB, vB, ldb); G8_STG(G8_SB(0, 1), cB + hB, vB, ldb); G8_STG(G8_SA(0, 0), cA, vA, lda); G8_STG(G8_SA(0, 1), cA + hA, vA, lda);
        if (wr == 1) G8_BAR;
        G8_WAIT_V(2); G8_BAR;
        G8_STG(G8_SB(1, 0), cB + 128, vB, ldb); G8_STG(G8_SA(1, 0), cA + 128, vA, lda); G8_STG(G8_SB(1, 1), cB + hB + 128, vB, ldb);
        G8_WAIT_V(6); G8_BAR;
    }
    for (;;) {
        const bool has_next = ph.get(ui + 1, nxt);
        const char* nA = has_next ? nxt.A : cA; const char* nB = has_next ? nxt.B : cB;
        const unsigned nlda = has_next ? nxt.lda : lda, nldb = has_next ? nxt.ldb : ldb;
        const unsigned nvA = (unsigned)((has_next ? nxt.permA : cur.permA) ? Ra : R) * nlda + C2, nvB = (unsigned)((has_next ? nxt.perm : cur.perm) ? Rp : R) * nldb + C2;
        const int nt = cur.nt;
        for (int t = 0; t < nt; t += 2) {
            const bool last = (t == nt - 2);
            const char* a1 = cA + (size_t)(t + 1) * 128;
            const char* a2 = last ? nA : cA + (size_t)(t + 2) * 128; const char* b2 = last ? nB : cB + (size_t)(t + 2) * 128;
            const unsigned xlda = last ? nlda : lda, xldb = last ? nldb : ldb, xvA = last ? nvA : vA, xvB = last ? nvB : vB;
            const unsigned xhA = 128u * xlda, xhB = 128u * xldb;
            const char* a3 = a2 + 128; const char* b3 = b2 + 128;
            G8_LDB(B0, 0, 0); G8_LDB(B1, 0, 1); G8_SCHED; G8_LDA(At, 0, 0); G8_STG(G8_SA(1, 1), a1 + 128u * lda, vA, lda);
            G8_WAIT_V(8); G8_WAIT_L(0); G8_BAR; G8_MMA(0, 0, At, B0); G8_MMA(0, 1, At, B1); G8_BAR; G8_SCHED;
            G8_LDA(At, 0, 1); G8_STG(G8_SB(0, 0), b2, xvB, xldb); G8_STG(G8_SB(0, 1), b2 + xhB, xvB, xldb); G8_STG(G8_SA(0, 0), a2, xvA, xlda);
            G8_WAIT_V(8); G8_WAIT_L(0); G8_BAR; G8_MMA(1, 0, At, B0); G8_MMA(1, 1, At, B1); G8_BAR; G8_SCHED;
            G8_LDB(B0, 1, 0); G8_LDB(B1, 1, 1); G8_SCHED; G8_LDA(At, 1, 0); G8_STG(G8_SA(0, 1), a2 + xhA, xvA, xlda);
            G8_WAIT_V(8); G8_WAIT_L(0); G8_BAR; G8_MMA(0, 0, At, B0); G8_MMA(0, 1, At, B1); G8_BAR; G8_SCHED;
            G8_LDA(At, 1, 1); G8_STG(G8_SB(1, 0), b3, xvB, xldb); G8_STG(G8_SB(1, 1), b3 + xhB, xvB, xldb); G8_STG(G8_SA(1, 0), a3, xvA, xlda);
            G8_WAIT_V(8); G8_WAIT_L(0); G8_BAR; G8_MMA(1, 0, At, B0); G8_MMA(1, 1, At, B1); G8_BAR; G8_SCHED;
        }
        if (wr == 0) G8_BAR;
        ph.epi(acc, cur, lds, tid, wid, lane, wr, wc, fr, fq);
        if (!has_next) break;
        if (nxt.zero) {
#pragma unroll
            for (int a = 0; a < 2; ++a)
#pragma unroll
                for (int b = 0; b < 2; ++b)
#pragma unroll
                    for (int m = 0; m < 4; ++m)
#pragma unroll
                        for (int n = 0; n < 2; ++n) acc[a][b][m][n] = (f32x4){0.f, 0.f, 0.f, 0.f};
        }
        cur = nxt; cA = nA; cB = nB; lda = nlda; ldb = nldb; vA = nvA; vB = nvB; ++ui;
        if (wr == 1) G8_BAR;
    }
    G8_WAIT_V(0);
    G8_BAR;
#undef G8_SA
#undef G8_SB
#undef G8_STG
#undef G8_LDA
#undef G8_LDB
#undef G8_MMA
#undef G8_WAIT_V
#undef G8_WAIT_L
#undef G8_BAR
#undef G8_SCHED
}
}
using g8::UnitD;
typedef f32x4 Acc[2][2][4][2];

struct Args { const float* in[27]; float* out; unsigned char* ws; };
struct Ctx {
    const Args& a;
    unsigned char* ws; float* out;
    int G, bid, layer;
};
DI bf16_t* wt_ptr(const Ctx& c, size_t off) { return (bf16_t*)(c.ws + WS_WT) + (size_t)c.layer * W_LAYER + off; }
DI bf16_t* XBp(const Ctx& c) { return (bf16_t*)(c.ws + WS_XB); }
DI bf16_t* Hp(const Ctx& c) { return (bf16_t*)(c.ws + WS_H); }
DI float* XFp(const Ctx& c) { return c.out + O_Y; }
DI float* HALOp(const Ctx& c) { return (float*)(c.ws + WS_HALO); }


DI bool splitk_combine(Acc& acc, unsigned char* ws, const UnitD& u, int inst, int tid, int wid, int lane) {
    unsigned long long* buf = (unsigned long long*)(ws + WS_PART) + (size_t)u.slot * 64 * 512;
    unsigned* flag = (unsigned*)(ws + WS_PFLAG) + (inst * 16 + u.slot) * 64;
    const bool sec = (u.split == 2);
    if (!sec) {
        if (wid == 0) { unsigned sp = 0; while ((unsigned)__builtin_amdgcn_readfirstlane(__hip_atomic_load(flag, __ATOMIC_RELAXED, __HIP_MEMORY_SCOPE_AGENT)) < 8u) { __builtin_amdgcn_s_sleep(2); if (++sp > (1u << 22)) break; } }
        asm volatile("s_waitcnt vmcnt(0) lgkmcnt(0)" ::: "memory"); __builtin_amdgcn_s_barrier(); asm volatile("" ::: "memory");
    }
#pragma unroll
    for (int ai = 0; ai < 2; ++ai)
#pragma unroll
        for (int bj = 0; bj < 2; ++bj) {
            unsigned long long* p = (buf + ((ai * 2 + bj) * 16) * 512) + tid;
            if (sec) {
#pragma unroll
                for (int m = 0; m < 4; ++m)
#pragma unroll
                    for (int n = 0; n < 2; ++n) { const f32x4 v = acc[ai][bj][m][n]; const int q = (m * 2 + n) * 2;
                        __hip_atomic_store(p + q * 512, ((unsigned long long)__float_as_uint(v.y) << 32) | __float_as_uint(v.x), __ATOMIC_RELAXED, __HIP_MEMORY_SCOPE_AGENT);
                        __hip_atomic_store(p + (q + 1) * 512, ((unsigned long long)__float_as_uint(v.w) << 32) | __float_as_uint(v.z), __ATOMIC_RELAXED, __HIP_MEMORY_SCOPE_AGENT); }
            } else {
                unsigned long long w[16];
#pragma unroll
                for (int q = 0; q < 16; ++q) w[q] = __hip_atomic_load(p + q * 512, __ATOMIC_RELAXED, __HIP_MEMORY_SCOPE_AGENT);
#pragma unroll
                for (int m = 0; m < 4; ++m)
#pragma unroll
                    for (int n = 0; n < 2; ++n) { const int q = (m * 2 + n) * 2;
                        acc[ai][bj][m][n] += (f32x4){__uint_as_float((unsigned)w[q]), __uint_as_float((unsigned)(w[q] >> 32)), __uint_as_float((unsigned)w[q + 1]), __uint_as_float((unsigned)(w[q + 1] >> 32))}; }
            }
            asm volatile("" ::: "memory");
        }
    if (sec) {
        asm volatile("s_waitcnt vmcnt(0)" ::: "memory");
        if (lane == 0) __hip_atomic_fetch_add(flag, 1u, __ATOMIC_RELAXED, __HIP_MEMORY_SCOPE_AGENT);
    }
    return sec;
}

DI void store_tile_bf16_perm(const Acc& acc, bf16_t* base  , size_t ld, int wr, int wc, int fr, int fq) {
#pragma unroll
    for (int ai = 0; ai < 2; ++ai)
#pragma unroll
        for (int m = 0; m < 4; ++m) {
            bf16_t* rowp = base + (size_t)(ai * 128 + wr * 64 + m * 16 + fr) * ld + wc * 32 + 8 * fq;
#pragma unroll
            for (int bj = 0; bj < 2; ++bj) {
                const f32x4 v0 = acc[ai][bj][m][0], v1 = acc[ai][bj][m][1];
                u32x4 w; w.x = cvt_pk_bf16(v0[0], v0[1]); w.y = cvt_pk_bf16(v0[2], v0[3]); w.z = cvt_pk_bf16(v1[0], v1[1]); w.w = cvt_pk_bf16(v1[2], v1[3]);
                *(u32x4*)(rowp + bj * 128) = w;
            }
        }
}

struct PhIn {
    Ctx c;
    DI bool get(int i, UnitD& u) const {
        const long L = (long)i * c.G + c.bid; if (L >= 132 * 25) return false;
        int pm, pn; g8::tile_of((int)L, 132, 25, pm, pn);
        u.A = (const char*)(XBp(c) + (size_t)pm * 256 * DM); u.B = (const char*)(wt_ptr(c, W_IN) + (size_t)pn * 256 * DM);
        u.lda = DM * 2; u.ldb = DM * 2; u.nt = DM / 64; u.pm = pm; u.pn = pn; u.sub = 0; u.split = 0; u.slot = 0; u.permA = false; u.zero = true; u.perm = true; return true;
    }
    DI void epi(Acc& acc, const UnitD& u, LAS unsigned char* lds, int tid, int wid, int lane, int wr, int wc, int fr, int fq) const {
        asm volatile("" : "+v"(fr), "+v"(fq), "+v"(tid));
        const bool isG = u.pn >= 13;
        const int gc = (isG ? (u.pn - 13) * 256 : 0) + wc * 32 + 8 * fq;
        const float* bg = c.a.in[8] + (size_t)c.layer * NGATE + gc;
        unsigned char* gbase = c.ws + WS_GS + (size_t)u.pm * 256 * NGATE + gc;
        bf16_t* hbase = Hp(c) + (size_t)u.pm * 256 * LDH + (isG ? 0 : u.pn * 256) + wc * 32 + 8 * fq;
#pragma unroll
        for (int ai = 0; ai < 2; ++ai)
#pragma unroll
            for (int m = 0; m < 4; ++m) {
                const int row = ai * 128 + wr * 64 + m * 16 + fr;
#pragma unroll
                for (int bj = 0; bj < 2; ++bj) {
                    f32x4 v0 = acc[ai][bj][m][0], v1 = acc[ai][bj][m][1];
                    if (isG) {
                        const f32x4 nb0 = *(const f32x4*)(bg + bj * 128) * -1.44269504089f, nb1 = *(const f32x4*)(bg + bj * 128 + 4) * -1.44269504089f;
                        unsigned q[8];
#pragma unroll
                        for (int e = 0; e < 4; ++e) {
                            const float t0 = __builtin_amdgcn_exp2f(__builtin_fmaf(v0[e], -1.44269504089f, nb0[e])), t1 = __builtin_amdgcn_exp2f(__builtin_fmaf(v1[e], -1.44269504089f, nb1[e]));
                            const unsigned a0 = (unsigned)__builtin_fmaf(__builtin_amdgcn_rcpf(1.f + t0), 255.f, 0.5f), a1 = (unsigned)__builtin_fmaf(__builtin_amdgcn_rcpf(1.f + t1), 255.f, 0.5f);
                            q[e] = a0 > 1u ? a0 : 1u; q[4 + e] = a1 > 1u ? a1 : 1u;
                        }
                        u32x2 w; w.x = q[0] | (q[1] << 8) | (q[2] << 16) | (q[3] << 24); w.y = q[4] | (q[5] << 8) | (q[6] << 16) | (q[7] << 24);
                        *(u32x2*)(gbase + (size_t)row * NGATE + bj * 128) = w;
                    } else {
                        u32x4 w; w.x = cvt_pk_bf16(v0[0], v0[1]); w.y = cvt_pk_bf16(v0[2], v0[3]); w.z = cvt_pk_bf16(v1[0], v1[1]); w.w = cvt_pk_bf16(v1[2], v1[3]);
                        *(u32x4*)(hbase + (size_t)row * LDH + bj * 128) = w;
                    }
                }
            }
    }
};

struct PhMerge {
    Ctx c;
    DI bool get(int i, UnitD& u) const {
        const int ti = i / 3, j = i - ti * 3;
        const int full = 528 / c.G, tail = 528 - full * c.G;
        int L, kh = 0; u.split = 0; u.slot = 0; u.permA = false;
        if (ti < full) L = ti * c.G + c.bid;
        else if (ti == full && 2 * tail <= c.G && tail <= 16) { if (c.bid >= 2 * tail) return false; L = full * c.G + (c.bid >> 1); kh = c.bid & 1; u.split = 1 + kh; u.slot = c.bid >> 1; }
        else if (ti == full) { L = ti * c.G + c.bid; if (L >= 528) return false; }
        else return false;
        int pm, pn; g8::tile_of(L, 132, 4, pm, pn);
        u.pm = pm; u.pn = pn; u.sub = j; u.perm = true;
        const int co = j == 0 ? QO : (j == 1 ? GUO : SBO);
        const int kn = u.split ? 256 : 512;
        u.A = (const char*)(Hp(c) + (size_t)pm * 256 * LDH + co + kh * kn); u.B = (const char*)(wt_ptr(c, W_PA) + (size_t)j * 512 * 1024 + (size_t)pn * 256 * 512 + kh * kn);
        u.lda = LDH * 2; u.ldb = 512 * 2; u.nt = kn / 64; u.zero = (j == 0);
        return true;
    }
    DI void epi(Acc& acc, const UnitD& u, LAS unsigned char* lds, int tid, int wid, int lane, int wr, int wc, int fr, int fq) const {
        asm volatile("" : "+v"(fr), "+v"(fq), "+v"(tid));
        const int j = u.sub; const bool lastj = (j == 2);
        const unsigned char* gp = c.ws + WS_GS + (size_t)(u.pm * 256 + wr * 64 + fr) * NGATE + j * 1024 + u.pn * 256 + wc * 32 + 8 * fq;
        u32x2 qa[16], qb[16];
#pragma unroll
        for (int ai = 0; ai < 2; ++ai)
#pragma unroll
            for (int m = 0; m < 4; ++m)
#pragma unroll
                for (int bj = 0; bj < 2; ++bj) {
                    const int k = (ai * 4 + m) * 2 + bj;
                    const unsigned char* p = gp + (size_t)(ai * 128 + m * 16) * NGATE + bj * 128;
                    qa[k] = *(const u32x2*)p;
                    qb[k] = (u32x2){0xffffffffu, 0xffffffffu};
                    if (!lastj) qb[k] = *(const u32x2*)(p + 1024);
                }
        asm volatile("" ::: "memory");
#pragma unroll
        for (int ai = 0; ai < 2; ++ai)
#pragma unroll
            for (int m = 0; m < 4; ++m)
#pragma unroll
                for (int bj = 0; bj < 2; ++bj) {
                    const int k = (ai * 4 + m) * 2 + bj;
                    const u32x2 a = qa[k], b = qb[k];
                    f32x4 s0, s1;
                    s0[0] = (float)(a.x & 0xff) * __builtin_amdgcn_rcpf((float)(b.x & 0xff)); s0[1] = (float)((a.x >> 8) & 0xff) * __builtin_amdgcn_rcpf((float)((b.x >> 8) & 0xff));
                    s0[2] = (float)((a.x >> 16) & 0xff) * __builtin_amdgcn_rcpf((float)((b.x >> 16) & 0xff)); s0[3] = (float)(a.x >> 24) * __builtin_amdgcn_rcpf((float)(b.x >> 24));
                    s1[0] = (float)(a.y & 0xff) * __builtin_amdgcn_rcpf((float)(b.y & 0xff)); s1[1] = (float)((a.y >> 8) & 0xff) * __builtin_amdgcn_rcpf((float)((b.y >> 8) & 0xff));
                    s1[2] = (float)((a.y >> 16) & 0xff) * __builtin_amdgcn_rcpf((float)((b.y >> 16) & 0xff)); s1[3] = (float)(a.y >> 24) * __builtin_amdgcn_rcpf((float)(b.y >> 24));
                    acc[ai][bj][m][0] *= s0; acc[ai][bj][m][1] *= s1;
                }
        if (lastj) {
            if (u.split && splitk_combine(acc, c.ws, u, c.layer * 3 + 0, tid, wid, lane)) return;
            store_tile_bf16_perm(acc, Hp(c) + (size_t)u.pm * 256 * LDH + MGO + u.pn * 256, LDH, wr, wc, fr, fq);
        }
    }
};

typedef float f32x2v __attribute__((ext_vector_type(2)));
struct PhRes {
    Ctx c; int which;
    DI bool get(int i, UnitD& u) const {
        const int vcu = (c.G & 7) == 0 ? (c.bid & 7) * (c.G >> 3) + (c.bid >> 3) : c.bid;
        const int full = 528 / c.G, tail = 528 - full * c.G;
        int L, kh = 0; u.split = 0; u.slot = 0; u.permA = false;
        if (i < full) L = i * c.G + vcu;
        else if (i == full && 2 * tail <= c.G && tail <= 16) { if (vcu >= 2 * tail) return false; L = full * c.G + (vcu >> 1); kh = vcu & 1; u.split = 1 + kh; u.slot = vcu >> 1; }
        else if (i == full) { L = i * c.G + vcu; if (L >= 528) return false; }
        else return false;
        const int pm = L >> 2, pn = L & 3;
        u.pm = pm; u.pn = pn; u.sub = 0; u.zero = true; u.perm = true;
        if (which == 0) { const int kn = u.split ? 512 : 1024; u.A = (const char*)(Hp(c) + (size_t)pm * 256 * LDH + MGO + kh * kn); u.lda = LDH * 2; u.B = (const char*)(wt_ptr(c, W_O) + (size_t)pn * 256 * 1024 + kh * kn); u.ldb = 1024 * 2; u.nt = kn / 64; }
        else { const int kn = u.split ? DFF / 2 : DFF; u.A = (const char*)(Hp(c) + (size_t)pm * 256 * DFF + kh * kn); u.lda = DFF * 2; u.B = (const char*)(wt_ptr(c, W_DN) + (size_t)pn * 256 * DFF + kh * kn); u.ldb = DFF * 2; u.nt = kn / 64; }
        return true;
    }
    DI void epi(Acc& acc, const UnitD& u, LAS unsigned char* lds, int tid, int wid, int lane, int wr, int wc, int fr, int fq) const {
        asm volatile("" : "+v"(fr), "+v"(fq), "+v"(tid), "+v"(lane));
        if (u.split && splitk_combine(acc, c.ws, u, c.layer * 3 + 1 + which, tid, wid, lane)) return;
        float* outp = XFp(c) + (size_t)u.pm * 256 * DM;
        bf16_t* outb = XBp(c) + (size_t)u.pm * 256 * DM;
        const bool final_out = (which == 1 && c.layer == 1);
        const int col0 = u.pn * 256 + wc * 32 + 8 * fq;
        const unsigned loff = (unsigned)((wr * 64 + fr) * DM + col0);
        {
            u32x4 r[2][4][2];
#pragma unroll
            for (int ai = 0; ai < 2; ++ai)
#pragma unroll
                for (int m = 0; m < 4; ++m)
#pragma unroll
                    for (int bj = 0; bj < 2; ++bj) r[ai][m][bj] = *(const u32x4*)((outb + ((ai * 128 + m * 16) * DM + bj * 128)) + loff);
            asm volatile("" ::: "memory");
#pragma unroll
            for (int ai = 0; ai < 2; ++ai)
#pragma unroll
                for (int m = 0; m < 4; ++m)
#pragma unroll
                    for (int bj = 0; bj < 2; ++bj) { const u32x4 w = r[ai][m][bj];
                        acc[ai][bj][m][0] = (f32x4){bf_lo(w.x), bf_hi(w.x), bf_lo(w.y), bf_hi(w.y)} * ALPHA + acc[ai][bj][m][0];
                        acc[ai][bj][m][1] = (f32x4){bf_lo(w.z), bf_hi(w.z), bf_lo(w.w), bf_hi(w.w)} * ALPHA + acc[ai][bj][m][1]; }
            asm volatile("" ::: "memory");
        }
        const float* lg = c.a.in[which == 0 ? 19 : 25] + c.layer * DM + col0; const float* lb = c.a.in[which == 0 ? 20 : 26] + c.layer * DM + col0;
        f32x4 g4[2][2], b4[2][2];
#pragma unroll
        for (int bj = 0; bj < 2; ++bj)
#pragma unroll
            for (int n = 0; n < 2; ++n) { g4[bj][n] = *(const f32x4*)(lg + bj * 128 + n * 4); b4[bj][n] = *(const f32x4*)(lb + bj * 128 + n * 4); }
        LAS f32x2v* P = (LAS f32x2v*)(lds + XL_OFF);
        LAS f32x2v* S = (LAS f32x2v*)(lds + XL_OFF + 8192);
        const int inst = c.layer * 2 + which;
        unsigned long long* xbuf = (unsigned long long*)(c.ws + WS_XBUF + (size_t)inst * XBUF_INST);
        unsigned* cnt = (unsigned*)(c.ws + WS_CNT) + ((size_t)inst * 132 + u.pm) * 64;
#pragma unroll
        for (int ai = 0; ai < 2; ++ai)
#pragma unroll
            for (int m = 0; m < 4; ++m) {
                float sm = 0.f;
#pragma unroll
                for (int bj = 0; bj < 2; ++bj)
#pragma unroll
                    for (int n = 0; n < 2; ++n) { const f32x4 x = acc[ai][bj][m][n]; sm += (x[0] + x[1]) + (x[2] + x[3]); }
                sm += __shfl_xor(sm, 16); sm += __shfl_xor(sm, 32);
                const float mw = sm * (1.0f / 64.0f); float q = 0.f;
#pragma unroll
                for (int bj = 0; bj < 2; ++bj)
#pragma unroll
                    for (int n = 0; n < 2; ++n) { const f32x4 d = acc[ai][bj][m][n] - mw; q += (d[0] * d[0] + d[1] * d[1]) + (d[2] * d[2] + d[3] * d[3]); }
                q += __shfl_xor(q, 16); q += __shfl_xor(q, 32);
                P[(ai * 128 + wr * 64 + m * 16 + fr) * 4 + wc] = (f32x2v){mw, q};
            }
        asm volatile("s_waitcnt lgkmcnt(0)" ::: "memory"); __builtin_amdgcn_s_barrier(); asm volatile("" ::: "memory");
        const int prow = wid * 32 + (lane & 31);
        if (lane < 32) {
            const f32x2v a = P[prow * 4 + 0], b = P[prow * 4 + 1], cc = P[prow * 4 + 2], d = P[prow * 4 + 3];
            const float mt = (a.x + b.x + cc.x + d.x) * 0.25f;
            const float da = a.x - mt, db = b.x - mt, dc = cc.x - mt, dd = d.x - mt;
            const float m2 = (a.y + b.y) + (cc.y + d.y) + 64.0f * ((da * da + db * db) + (dc * dc + dd * dd));
            __hip_atomic_store(xbuf + ((size_t)(u.pm * 256 + prow) * 4 + u.pn), ((unsigned long long)__float_as_uint(m2) << 32) | __float_as_uint(mt), __ATOMIC_RELAXED, __HIP_MEMORY_SCOPE_AGENT);
        }
        asm volatile("s_waitcnt vmcnt(0)" ::: "memory");
        if (lane == 0) __hip_atomic_fetch_add(cnt, 1u, __ATOMIC_RELAXED, __HIP_MEMORY_SCOPE_AGENT);
        if (wid == 0) {
            unsigned sp = 0;
            while ((unsigned)__builtin_amdgcn_readfirstlane(__hip_atomic_load(cnt, __ATOMIC_RELAXED, __HIP_MEMORY_SCOPE_AGENT)) < 32u) { __builtin_amdgcn_s_sleep(2); if (++sp > (1u << 22)) break; }
        }
        asm volatile("s_waitcnt vmcnt(0) lgkmcnt(0)" ::: "memory"); __builtin_amdgcn_s_barrier(); asm volatile("" ::: "memory");
        if (lane < 32) {
            const unsigned long long* slot = xbuf + (size_t)(u.pm * 256 + prow) * 4;
            float mt[4], m2[4]; float ms = 0.f;
#pragma unroll
            for (int t = 0; t < 4; ++t) { const unsigned long long w = __hip_atomic_load(slot + t, __ATOMIC_RELAXED, __HIP_MEMORY_SCOPE_AGENT); mt[t] = __uint_as_float((unsigned)w); m2[t] = __uint_as_float((unsigned)(w >> 32)); ms += mt[t]; }
            const float mean = ms * 0.25f; float q = 0.f;
#pragma unroll
            for (int t = 0; t < 4; ++t) { const float dm = mt[t] - mean; q += m2[t] + 256.0f * dm * dm; }
            S[prow] = (f32x2v){mean, 1.0f / sqrtf(q * (1.0f / 1024.0f) + LN_EPS)};
        }
        asm volatile("s_waitcnt lgkmcnt(0)" ::: "memory"); __builtin_amdgcn_s_barrier(); asm volatile("" ::: "memory");
#pragma unroll
        for (int ai = 0; ai < 2; ++ai)
#pragma unroll
            for (int m = 0; m < 4; ++m) {
                const int r = ai * 128 + wr * 64 + m * 16 + fr; const f32x2v sr = S[r];
#pragma unroll
                for (int bj = 0; bj < 2; ++bj) {
                    const f32x4 o0 = (acc[ai][bj][m][0] - sr.x) * sr.y * g4[bj][0] + b4[bj][0], o1 = (acc[ai][bj][m][1] - sr.x) * sr.y * g4[bj][1] + b4[bj][1];
                    if (final_out) { float* yp = (outp + ((ai * 128 + m * 16) * DM + bj * 128)) + loff; *(f32x4*)yp = o0; *(f32x4*)(yp + 4) = o1; }
                    else { u32x4 w; w.x = cvt_pk_bf16(o0[0], o0[1]); w.y = cvt_pk_bf16(o0[2], o0[3]); w.z = cvt_pk_bf16(o1[0], o1[1]); w.w = cvt_pk_bf16(o1[2], o1[3]);
                        *(u32x4*)((outb + ((ai * 128 + m * 16) * DM + bj * 128)) + loff) = w; }
                }
                if (m & 1) asm volatile("" ::: "memory");
            }
    }
};

struct PhUp {
    Ctx c;
    DI bool get(int i, UnitD& u) const {
        const long L = (long)i * c.G + c.bid; if (L >= 132 * 22) return false;
        int pm, pn; g8::tile_of((int)L, 132, 22, pm, pn);
        u.A = (const char*)(XBp(c) + (size_t)pm * 256 * DM); u.B = (const char*)(wt_ptr(c, W_UP) + (size_t)pn * 256 * DM);
        u.lda = DM * 2; u.ldb = DM * 2; u.nt = DM / 64; u.pm = pm; u.pn = pn; u.sub = 0; u.split = 0; u.slot = 0; u.zero = true; u.perm = true; u.permA = true; return true;
    }
    DI void epi(Acc& acc, const UnitD& u, LAS unsigned char* lds, int tid, int wid, int lane, int wr, int wc, int fr, int fq) const {
        asm volatile("" : "+v"(fr), "+v"(fq), "+v"(tid));
        LAS float* HL = (LAS float*)(lds + HL_OFF);
        const bool samp = u.pm >= 128;
        const int tcol = wc * 32 + 8 * fq;
        const int ocol = u.pn * 128 + tcol;
        if (fr == 15) {
#pragma unroll
            for (int ai = 0; ai < 2; ++ai)
#pragma unroll
                for (int bj = 0; bj < 2; ++bj)
#pragma unroll
                    for (int n = 0; n < 2; ++n) {
                        *(LAS f32x4*)(HL + ((ai * 2 + wr) * 2 + 0) * 256 + bj * 128 + tcol + 4 * n) = acc[ai][bj][2][n];
                        *(LAS f32x4*)(HL + ((ai * 2 + wr) * 2 + 1) * 256 + bj * 128 + tcol + 4 * n) = acc[ai][bj][3][n];
                    }
        }
        asm volatile("s_waitcnt lgkmcnt(0)" ::: "memory"); __builtin_amdgcn_s_barrier(); asm volatile("" ::: "memory");
        const float* cw = c.a.in[22] + (size_t)c.layer * 3 * NUP; const float* cb = c.a.in[23] + (size_t)c.layer * NUP;
        float* halo = HALOp(c) + (size_t)u.pm * 4 * NUP;
        bf16_t* act = Hp(c) + (size_t)u.pm * 256 * DFF + u.pn * 128 + tcol;
        const bool even = (fr & 1) == 0;
        const f32x4 zero4 = {0.f, 0.f, 0.f, 0.f};
#pragma unroll
        for (int n = 0; n < 2; ++n) {
            f32x4 w0[2], w1[2], w2[2], bb[2];
#pragma unroll
            for (int bj = 0; bj < 2; ++bj) { const int oc = ocol + bj * DFF + 4 * n; w0[bj] = *(const f32x4*)(cw + oc); w1[bj] = *(const f32x4*)(cw + NUP + oc); w2[bj] = *(const f32x4*)(cw + 2 * NUP + oc); bb[bj] = *(const f32x4*)(cb + oc); }
#pragma unroll
            for (int ai = 0; ai < 2; ++ai) {
                const int row0 = ai * 128 + wr * 64 + 4 * fr;
                f32x4 cv[4][2];
#pragma unroll
                for (int bj = 0; bj < 2; ++bj) {
                    const int oc = ocol + bj * DFF + 4 * n;
                    f32x4 o3 = zero4, o2 = zero4;
                    f32x4 past0 = zero4, past1 = zero4;
                    if (!samp) {
                        const int sblk = ai * 2 + wr - 1;
                        if (sblk >= 0) { o2 = *(const LAS f32x4*)(HL + (sblk * 2 + 0) * 256 + bj * 128 + tcol + 4 * n); o3 = *(const LAS f32x4*)(HL + (sblk * 2 + 1) * 256 + bj * 128 + tcol + 4 * n); }
                    } else if (even) {
                        const int bglob = ((u.pm - 128) * 256 + row0) >> 3;
                        const float* st = c.a.in[5] + ((size_t)(c.layer * DB + bglob) * 2) * NUP + oc;
                        past0 = *(const f32x4*)st; past1 = *(const f32x4*)(st + NUP);
                    }
                    const f32x4 v0 = acc[ai][bj][0][n], v1 = acc[ai][bj][1][n], v2 = acc[ai][bj][2][n], v3 = acc[ai][bj][3][n];
                    f32x4 s3 = dppo4<0x111>(o3, v3), s2 = dppo4<0x111>(o2, v2);
                    f32x4 p1_0 = s3, p2_0 = s2, p2_1 = s3;
                    if (samp && even) { p1_0 = past1; p2_0 = past0; p2_1 = past1; }
                    cv[0][bj] = w0[bj] * p2_0 + w1[bj] * p1_0 + w2[bj] * v0 + bb[bj];
                    cv[1][bj] = w0[bj] * p2_1 + w1[bj] * v0 + w2[bj] * v1 + bb[bj];
                    cv[2][bj] = w0[bj] * v0 + w1[bj] * v1 + w2[bj] * v2 + bb[bj];
                    cv[3][bj] = w0[bj] * v1 + w1[bj] * v2 + w2[bj] * v3 + bb[bj];
                    if (!samp) {
                        if (ai == 0 && wr == 0 && fr == 0) { *(f32x4*)(halo + oc) = v0; *(f32x4*)(halo + (size_t)NUP + oc) = v1; }
                        if (ai == 1 && wr == 1 && fr == 15) {
                            *(f32x4*)(halo + (size_t)2 * NUP + oc) = v2; *(f32x4*)(halo + (size_t)3 * NUP + oc) = v3;
                            if ((u.pm & 7) == 7) { float* fo = c.out + O_FCP + ((size_t)(c.layer * NB + (u.pm >> 3)) * 2) * NUP + oc; *(f32x4*)fo = v2; *(f32x4*)(fo + NUP) = v3; }
                        }
                    } else if (!even) {
                        const int bglob = ((u.pm - 128) * 256 + row0) >> 3;
                        float* fo = c.out + O_FCS + ((size_t)(c.layer * DB + bglob) * 2) * NUP + oc; *(f32x4*)fo = v2; *(f32x4*)(fo + NUP) = v3;
                    }
                }
#pragma unroll
                for (int m = 0; m < 4; ++m) {
                    f32x4 o;
#pragma unroll
                    for (int e = 0; e < 4; ++e) { const float g = cv[m][1][e]; o[e] = cv[m][0][e] * g * __builtin_amdgcn_rcpf(1.f + fast_exp(-g)); }
                    u32x2 w; w.x = cvt_pk_bf16(o[0], o[1]); w.y = cvt_pk_bf16(o[2], o[3]);
                    *(u32x2*)(act + (size_t)(row0 + m) * DFF + 4 * n) = w;
                }
            }
        }
    }
};

DI void transpose_item(const float* W, int K, int N, bf16_t* WT, int mode, LAS float* scr, int item, int lane) {
    const int nblk = N / 32, kb = item / nblk, nb = item % nblk, k0 = 64 * kb, n0 = 32 * nb;
    float wv[32];
#pragma unroll
    for (int i = 0; i < 32; ++i) wv[i] = W[(size_t)(k0 + 2 * i + (lane >> 5)) * N + n0 + (lane & 31)];
#pragma unroll
    for (int i = 0; i < 32; ++i) scr[(2 * i + (lane >> 5)) * 33 + (lane & 31)] = wv[i];
    asm volatile("s_waitcnt lgkmcnt(0)" ::: "memory");
    int r0 = n0;
    if (mode == 1) { const int half = n0 / DFF, cc = n0 - half * DFF; r0 = (cc / 128) * 256 + half * 128 + (cc & 127); }
    const int cch = lane & 7;
#pragma unroll
    for (int j = 0; j < 4; ++j) { const int n = (lane >> 3) + 8 * j; const LAS float* s = scr + (8 * cch) * 33 + n;
        u32x4 o; o.x = cvt_pk_bf16(s[0 * 33], s[1 * 33]); o.y = cvt_pk_bf16(s[2 * 33], s[3 * 33]); o.z = cvt_pk_bf16(s[4 * 33], s[5 * 33]); o.w = cvt_pk_bf16(s[6 * 33], s[7 * 33]);
        *(u32x4*)(WT + (size_t)(r0 + n) * K + k0 + 8 * cch) = o; }
    asm volatile("s_waitcnt lgkmcnt(0)" ::: "memory");
}
constexpr int CW_IN = 16 * (NIN / 32), CW_G = 16 * (NGATE / 32), CW_P = 8 * 32, CW_O = 16 * 32, CW_UP = 16 * (NUP / 32), CW_DN = (DFF / 64) * 32;
constexpr int CW_A = CW_IN + CW_G + 3 * CW_P  , CW_B = CW_A + CW_O + CW_UP  , CW_ALL = CW_B + CW_DN;
DI void convert_layer_weights(const Ctx& c, int l, LAS float* scr, int gw, int NGW, int lane, int it_lo = 0, int it_hi = 1 << 30) {
    constexpr int I_IN = 16 * (NIN / 32), I_G = 16 * (NGATE / 32), I_P = 8 * 32, I_O = 16 * 32, I_UP = 16 * (NUP / 32), I_DN = (DFF / 64) * 32;
    constexpr int I_LAYER = I_IN + I_G + 3 * I_P + I_O + I_UP + I_DN;
    bf16_t* wt = (bf16_t*)(c.ws + WS_WT) + (size_t)l * W_LAYER;
    const int hi_ = it_hi < I_LAYER ? it_hi : I_LAYER;
    for (int it = it_lo + gw; it < hi_; it += NGW) {
        int r = it;
        if (r < I_IN) { transpose_item(c.a.in[6] + (size_t)l * DM * NIN, DM, NIN, wt + W_IN, 0, scr, r, lane); continue; } r -= I_IN;
        if (r < I_G) { transpose_item(c.a.in[7] + (size_t)l * DM * NGATE, DM, NGATE, wt + W_G, 0, scr, r, lane); continue; } r -= I_G;
        if (r < I_P) { transpose_item(c.a.in[15] + (size_t)l * 512 * 1024, 512, 1024, wt + W_PA, 0, scr, r, lane); continue; } r -= I_P;
        if (r < I_P) { transpose_item(c.a.in[16] + (size_t)l * 512 * 1024, 512, 1024, wt + W_PG, 0, scr, r, lane); continue; } r -= I_P;
        if (r < I_P) { transpose_item(c.a.in[17] + (size_t)l * 512 * 1024, 512, 1024, wt + W_PC, 0, scr, r, lane); continue; } r -= I_P;
        if (r < I_O) { transpose_item(c.a.in[18] + (size_t)l * 1024 * 1024, 1024, 1024, wt + W_O, 0, scr, r, lane); continue; } r -= I_O;
        if (r < I_UP) { transpose_item(c.a.in[21] + (size_t)l * DM * NUP, DM, NUP, wt + W_UP, 1, scr, r, lane); continue; } r -= I_UP;
        transpose_item(c.a.in[24] + (size_t)l * DFF * DM, DFF, DM, wt + W_DN, 0, scr, r, lane);
    }
}
DI void phase_prologue(const Ctx& c, LAS unsigned char* lds, int tid) {
    const int wave = tid >> 6, lane = tid & 63;
    LAS float* scr = (LAS float*)(lds + wave * 16384);
    const int gw = c.bid * 8 + wave, NGW = c.G * 8;
    convert_layer_weights(c, 0, scr, gw, NGW, lane, 0, CW_A);
    for (int m0 = gw * 4; m0 < MT; m0 += NGW * 4) {
        const float* src = m0 < MP ? c.a.in[0] + (size_t)m0 * DM : c.a.in[1] + (size_t)(m0 - MP) * DM;
        bf16_t* dst = XBp(c) + (size_t)m0 * DM;
        f32x4 v[4][4];
#pragma unroll
        for (int r = 0; r < 4; ++r)
#pragma unroll
            for (int j = 0; j < 4; ++j) v[r][j] = *(const f32x4*)(src + (size_t)r * DM + 4 * lane + 256 * j);
#pragma unroll
        for (int r = 0; r < 4; ++r)
#pragma unroll
            for (int j = 0; j < 4; ++j) { u32x2 w; w.x = cvt_pk_bf16(v[r][j].x, v[r][j].y); w.y = cvt_pk_bf16(v[r][j].z, v[r][j].w); *(u32x2*)(dst + (size_t)r * DM + 4 * lane + 256 * j) = w; }
    }
}

DI void phase_ln(const Ctx& c, const float* g, const float* b, int tid) {
    const int wave = tid >> 6, lane = tid & 63;
    const int gw = c.bid * 8 + wave, NGW = c.G * 8;
    f32x4 gv[4], bv[4];
#pragma unroll
    for (int j = 0; j < 4; ++j) { gv[j] = *(const f32x4*)(g + 4 * lane + 256 * j); bv[j] = *(const f32x4*)(b + 4 * lane + 256 * j); }
    for (int m = gw; m < MT; m += NGW) {
        float* xr = XFp(c) + (size_t)m * DM; bf16_t* xb = XBp(c) + (size_t)m * DM;
        f32x4 v[4]; float s = 0.f;
#pragma unroll
        for (int j = 0; j < 4; ++j) { v[j] = *(const f32x4*)(xr + 4 * lane + 256 * j); s += (v[j].x + v[j].y) + (v[j].z + v[j].w); }
        const float mean = wave_sum(s) * (1.f / DM); float s2 = 0.f;
#pragma unroll
        for (int j = 0; j < 4; ++j) { v[j] = v[j] - mean; s2 += (v[j].x * v[j].x + v[j].y * v[j].y) + (v[j].z * v[j].z + v[j].w * v[j].w); }
        const float rstd = 1.f / sqrtf(wave_sum(s2) * (1.f / DM) + LN_EPS);
#pragma unroll
        for (int j = 0; j < 4; ++j) { const f32x4 o = v[j] * rstd * gv[j] + bv[j]; *(f32x4*)(xr + 4 * lane + 256 * j) = o;
            u32x2 w; w.x = cvt_pk_bf16(o.x, o.y); w.y = cvt_pk_bf16(o.z, o.w); *(u32x2*)(xb + 4 * lane + 256 * j) = w; }
    }
}

DI void phase_fixup(const Ctx& c, int tid) {
    const float* cw = c.a.in[22] + (size_t)c.layer * 3 * NUP; const float* cb = c.a.in[23] + (size_t)c.layer * NUP;
    const float* halo = HALOp(c);
    bf16_t* act = Hp(c);
    for (int it = c.bid * 512 + tid; it < 128 * DFF; it += c.G * 512) {
        const int pm = it / DFF, col = it - pm * DFF;
        const float* h = halo + (size_t)pm * 4 * NUP;
        float cv[2][2];
#pragma unroll
        for (int bj = 0; bj < 2; ++bj) {
            const int oc = col + bj * DFF;
            const float v0 = h[oc], v1 = h[NUP + oc];
            float q2 = 0.f, q3 = 0.f;
            if ((pm & 7) != 0) { q2 = h[oc - 2 * (long)NUP]; q3 = h[oc - (long)NUP]; }
            const float w0 = cw[oc], w1 = cw[NUP + oc], w2 = cw[2 * NUP + oc], bb = cb[oc];
            cv[0][bj] = w0 * q2 + w1 * q3 + w2 * v0 + bb;
            cv[1][bj] = w0 * q3 + w1 * v0 + w2 * v1 + bb;
        }
#pragma unroll
        for (int r = 0; r < 2; ++r) { const float gg = cv[r][1]; act[(size_t)(pm * 256 + r) * DFF + col] = f2bf(cv[r][0] * gg * __builtin_amdgcn_rcpf(1.f + fast_exp(-gg))); }
    }
}

#define MFMA32(a, b, c) __builtin_amdgcn_mfma_f32_32x32x16_bf16((a), (b), (c), 0, 0, 0)
DI int crow(int r, int h) { return (r & 3) + 8 * (r >> 2) + 4 * h; }

DI void attn_prompt_item(const Ctx& c, LAS unsigned char* lds, int item, int tid) {
    asm volatile("" : "+v"(tid));
    const int hp = item & 1, kvh = (item >> 1) & 1, n = (item >> 2) & 15, b = item >> 6;
    const int wave = tid >> 6, lane = tid & 63, l31 = lane & 31, lh = lane >> 5;
    bf16_t* H = Hp(c);
    LAS bf16_t* Ks = (LAS bf16_t*)lds;
    LAS bf16_t* Vt = (LAS bf16_t*)(lds + 256 * 144);
    LAS bf16_t* Pb = (LAS bf16_t*)(lds + 256 * 144 + 64 * 528 + wave * 2560);
    const size_t row0 = (size_t)b * SEQ + (size_t)n * 128;
#pragma unroll
    for (int q = 0; q < 4; ++q) {
        const int ch = tid + 512 * q, kr = ch >> 3, part = ch & 7;
        u32x4 kv = (u32x4){0u, 0u, 0u, 0u}, vv = kv;
        if (n > 0 || kr >= 128) {
            const bf16_t* src = H + (row0 - 128 + kr) * LDH + kvh * 64 + part * 8;
            kv = *(const u32x4*)(src + KO); vv = *(const u32x4*)(src + VO);
        }
        *(LAS u32x4*)(Ks + kr * 72 + part * 8) = kv;
        const int d0 = part * 8;
        Vt[(d0 + 0) * 264 + kr] = (bf16_t)(vv.x & 0xffff); Vt[(d0 + 1) * 264 + kr] = (bf16_t)(vv.x >> 16);
        Vt[(d0 + 2) * 264 + kr] = (bf16_t)(vv.y & 0xffff); Vt[(d0 + 3) * 264 + kr] = (bf16_t)(vv.y >> 16);
        Vt[(d0 + 4) * 264 + kr] = (bf16_t)(vv.z & 0xffff); Vt[(d0 + 5) * 264 + kr] = (bf16_t)(vv.z >> 16);
        Vt[(d0 + 6) * 264 + kr] = (bf16_t)(vv.w & 0xffff); Vt[(d0 + 7) * 264 + kr] = (bf16_t)(vv.w >> 16);
    }
    __syncthreads();
    const int h = kvh * 4 + hp * 2 + (wave >> 2), a = wave & 3;
    const float slope = exp2f(-(float)(h + 1));
    const float sink = c.a.in[14][c.layer * 8 + h];
    bf16x8 qf[4];
    {
        const bf16_t* qp = H + (row0 + 32 * a + l31) * LDH + QO + h * 64 + 8 * lh;
#pragma unroll
        for (int ks = 0; ks < 4; ++ks) qf[ks] = *(const bf16x8*)(qp + 16 * ks);
    }
    f32x16 S[5];
#pragma unroll
    for (int kb = 0; kb < 5; ++kb) {
        f32x16 s;
#pragma unroll
        for (int r = 0; r < 16; ++r) s[r] = 0.f;
        const int j0 = 32 * a + 32 * kb;
#pragma unroll
        for (int ks = 0; ks < 4; ++ks) {
            const bf16x8 kf = *(const LAS bf16x8*)(Ks + (j0 + l31) * 72 + 16 * ks + 8 * lh);
            s = MFMA32(qf[ks], kf, s);
        }
        const int j = j0 + l31;
#pragma unroll
        for (int r = 0; r < 16; ++r) {
            const int i = 32 * a + crow(r, lh); const int dist = i + 128 - j;
            const bool ok = (dist >= 0) && (dist <= 128) && (n > 0 || j >= 128);
            s[r] = ok ? s[r] * 0.125f - slope * (float)dist : -1e30f;
        }
        S[kb] = s;
        asm volatile("" ::: "memory");
    }
    float drow[16];
#pragma unroll
    for (int r = 0; r < 16; ++r) {
        float mx = fmaxf(fmaxf(fmaxf(S[0][r], S[1][r]), fmaxf(S[2][r], S[3][r])), S[4][r]);
#pragma unroll
        for (int o = 1; o < 32; o <<= 1) mx = fmaxf(mx, __shfl_xor(mx, o));
        mx = fmaxf(mx, sink);
        float sm = 0.f;
#pragma unroll
        for (int kb = 0; kb < 5; ++kb) { const float p = fast_exp(S[kb][r] - mx); S[kb][r] = p; sm += p; }
#pragma unroll
        for (int o = 1; o < 32; o <<= 1) sm += __shfl_xor(sm, o);
        drow[r] = __builtin_amdgcn_rcpf(sm + fast_exp(sink - mx));
    }
    f32x16 O0, O1;
#pragma unroll
    for (int r = 0; r < 16; ++r) { O0[r] = 0.f; O1[r] = 0.f; }
#pragma unroll
    for (int kb = 0; kb < 5; ++kb) {
        const int j0 = 32 * a + 32 * kb;
#pragma unroll
        for (int r = 0; r < 16; ++r) Pb[crow(r, lh) * 40 + l31] = f2bf(S[kb][r]);
        asm volatile("s_waitcnt lgkmcnt(0)" ::: "memory");
#pragma unroll
        for (int k2 = 0; k2 < 2; ++k2) {
            const bf16x8 pf = *(const LAS bf16x8*)(Pb + l31 * 40 + 16 * k2 + 8 * lh);
            const bf16x8 v0 = *(const LAS bf16x8*)(Vt + l31 * 264 + j0 + 16 * k2 + 8 * lh);
            const bf16x8 v1 = *(const LAS bf16x8*)(Vt + (32 + l31) * 264 + j0 + 16 * k2 + 8 * lh);
            O0 = MFMA32(pf, v0, O0); O1 = MFMA32(pf, v1, O1);
        }
        asm volatile("s_waitcnt lgkmcnt(0)" ::: "memory");
    }
    {
        bf16_t* op = H + (row0 + 32 * a) * LDH + QO + h * 64 + l31;
#pragma unroll
        for (int r = 0; r < 16; ++r) { bf16_t* p = op + (size_t)crow(r, lh) * LDH; p[0] = f2bf(O0[r] * drow[r]); p[32] = f2bf(O1[r] * drow[r]); }
    }
    __syncthreads();
}

DI void attn_sample_item(const Ctx& c, LAS unsigned char* wl  , int item, int lane) {
    asm volatile("" : "+v"(lane));
    const int h = item & 7, b = item >> 3, kvh = h >> 2;
    bf16_t* H = Hp(c);
    LAS float* qs = (LAS float*)wl;
    LAS float* ps = (LAS float*)(wl + 2048);
    const size_t r0 = (size_t)MP + (size_t)b * 8;
    const float slope = exp2f(-(float)(h + 1));
    const float sink = c.a.in[14][c.layer * 8 + h];
#pragma unroll
    for (int i = 0; i < 8; ++i) qs[lane * 8 + i] = bf2f(H[(r0 + i) * LDH + QO + h * 64 + lane]);
    asm volatile("s_waitcnt lgkmcnt(0)" ::: "memory");
    const float* ck = c.a.in[2] + ((size_t)(c.layer * DB + b) * 128) * 128 + kvh * 64;
    const float* cv = c.a.in[3] + ((size_t)(c.layer * DB + b) * 128) * 128 + kvh * 64;
    float sc[3][8];
#pragma unroll
    for (int p = 0; p < 3; ++p) {
        const int j = lane + 64 * p;
        f32x4 kf[16];
        if (p < 2) {
            const float* kr = ck + (size_t)j * 128;
#pragma unroll
            for (int q4 = 0; q4 < 16; ++q4) kf[q4] = *(const f32x4*)(kr + 4 * q4);
        } else {
            const int jj = (j < 136) ? j - 128 : 0;
            const bf16_t* kr = H + (r0 + jj) * LDH + KO + kvh * 64;
#pragma unroll
            for (int q8 = 0; q8 < 8; ++q8) { const u32x4 w = *(const u32x4*)(kr + 8 * q8);
                kf[2 * q8] = (f32x4){bf_lo(w.x), bf_hi(w.x), bf_lo(w.y), bf_hi(w.y)}; kf[2 * q8 + 1] = (f32x4){bf_lo(w.z), bf_hi(w.z), bf_lo(w.w), bf_hi(w.w)}; }
        }
        float a8[8];
#pragma unroll
        for (int i = 0; i < 8; ++i) a8[i] = 0.f;
#pragma unroll
        for (int q4 = 0; q4 < 16; ++q4)
#pragma unroll
            for (int e = 0; e < 4; ++e) { const int d = 4 * q4 + e; const float kv = kf[q4][e];
                const f32x4 q0 = *(const LAS f32x4*)(qs + d * 8), q1 = *(const LAS f32x4*)(qs + d * 8 + 4);
                a8[0] += kv * q0[0]; a8[1] += kv * q0[1]; a8[2] += kv * q0[2]; a8[3] += kv * q0[3]; a8[4] += kv * q1[0]; a8[5] += kv * q1[1]; a8[6] += kv * q1[2]; a8[7] += kv * q1[3]; }
#pragma unroll
        for (int i = 0; i < 8; ++i) { const int dist = i + 128 - j; const bool ok = (j < 136) && dist >= 0 && dist <= 128; sc[p][i] = ok ? a8[i] * 0.125f - slope * (float)dist : -1e30f; }
        asm volatile("" ::: "memory");
    }
    float inv[8];
#pragma unroll
    for (int i = 0; i < 8; ++i) {
        const float mx = fmaxf(wave_max(fmaxf(fmaxf(sc[0][i], sc[1][i]), sc[2][i])), sink);
        float sm = 0.f;
#pragma unroll
        for (int p = 0; p < 3; ++p) { sc[p][i] = fast_exp(sc[p][i] - mx); sm += sc[p][i]; }
        inv[i] = 1.f / (wave_sum(sm) + fast_exp(sink - mx));
    }
#pragma unroll
    for (int p = 0; p < 3; ++p) { const int j = lane + 64 * p; if (j < 136) {
#pragma unroll
        for (int i = 0; i < 8; ++i) ps[j * 8 + i] = sc[p][i] * inv[i]; } }
    asm volatile("s_waitcnt lgkmcnt(0)" ::: "memory");
    float o[8];
#pragma unroll
    for (int i = 0; i < 8; ++i) o[i] = 0.f;
#pragma unroll 1
    for (int jb = 0; jb < 8; ++jb) {
        float vv[17];
#pragma unroll
        for (int u = 0; u < 17; ++u) { const int j = jb * 17 + u; vv[u] = j < 128 ? cv[(size_t)j * 128 + lane] : bf2f(H[(r0 + (j - 128)) * LDH + VO + kvh * 64 + lane]); }
#pragma unroll
        for (int u = 0; u < 17; ++u) { const int j = jb * 17 + u;
            const f32x4 p0 = *(const LAS f32x4*)(ps + j * 8), p1 = *(const LAS f32x4*)(ps + j * 8 + 4);
            o[0] += vv[u] * p0[0]; o[1] += vv[u] * p0[1]; o[2] += vv[u] * p0[2]; o[3] += vv[u] * p0[3]; o[4] += vv[u] * p1[0]; o[5] += vv[u] * p1[1]; o[6] += vv[u] * p1[2]; o[7] += vv[u] * p1[3]; }
    }
#pragma unroll
    for (int i = 0; i < 8; ++i) H[(r0 + i) * LDH + QO + h * 64 + lane] = f2bf(o[i]);
    asm volatile("s_waitcnt lgkmcnt(0)" ::: "memory");
}

DI void gmlp_prompt_item(const Ctx& c, LAS unsigned char* lds, int item, int tid) {
    asm volatile("" : "+v"(tid));
    const int wave = tid >> 6, lane = tid & 63, l31 = lane & 31, lh = lane >> 5;
    bf16_t* H = Hp(c);
    LAS bf16_t* VnT = (LAS bf16_t*)lds;
    const size_t row0 = (size_t)item * 128;
    const float* lg = c.a.in[9] + c.layer * 512; const float* lb = c.a.in[10] + c.layer * 512;
    float g8v[8], b8v[8];
#pragma unroll
    for (int e = 0; e < 8; ++e) { g8v[e] = lg[lane + 64 * e]; b8v[e] = lb[lane + 64 * e]; }
    bf16_t raw[16][8];
#pragma unroll
    for (int rr = 0; rr < 16; ++rr) { const bf16_t* src = H + (row0 + wave * 16 + rr) * LDH + GVO;
#pragma unroll
        for (int e = 0; e < 8; ++e) raw[rr][e] = src[lane + 64 * e]; }
#pragma unroll
    for (int rr = 0; rr < 16; ++rr) {
        const int s = wave * 16 + rr;
        float v[8]; float sm = 0.f;
#pragma unroll
        for (int e = 0; e < 8; ++e) { v[e] = bf2f(raw[rr][e]); sm += v[e]; }
        const float mean = wave_sum(sm) * (1.f / 512.f); float s2 = 0.f;
#pragma unroll
        for (int e = 0; e < 8; ++e) { v[e] -= mean; s2 += v[e] * v[e]; }
        const float rstd = 1.f / sqrtf(wave_sum(s2) * (1.f / 512.f) + LN_EPS);
#pragma unroll
        for (int e = 0; e < 8; ++e) VnT[(lane + 64 * e) * 136 + s] = f2bf(v[e] * rstd * g8v[e] + b8v[e]);
    }
    __syncthreads();
    const int g = wave >> 1, ch = wave & 1;
    const float* Ws = c.a.in[11] + ((size_t)(c.layer * 4 + g) * 128) * 128;
    f32x16 acc[4][2];
#pragma unroll
    for (int tb = 0; tb < 4; ++tb)
#pragma unroll
        for (int cb = 0; cb < 2; ++cb)
#pragma unroll
            for (int r = 0; r < 16; ++r) acc[tb][cb][r] = 0.f;
#pragma unroll
    for (int ks = 0; ks < 8; ++ks) {
        bf16x8 bfr[2];
#pragma unroll
        for (int cb = 0; cb < 2; ++cb) bfr[cb] = *(const LAS bf16x8*)(VnT + (g * 128 + ch * 64 + 32 * cb + l31) * 136 + 16 * ks + 8 * lh);
#pragma unroll
        for (int tb = 0; tb < 4; ++tb) {
            if (ks <= 2 * tb + 1) {
                const int t = 32 * tb + l31, s0 = 16 * ks + 8 * lh;
                const f32x4 w0 = *(const f32x4*)(Ws + (size_t)t * 128 + s0), w1 = *(const f32x4*)(Ws + (size_t)t * 128 + s0 + 4);
                u32x4 pk;
                pk.x = cvt_pk_bf16(s0 + 0 <= t ? w0[0] : 0.f, s0 + 1 <= t ? w0[1] : 0.f); pk.y = cvt_pk_bf16(s0 + 2 <= t ? w0[2] : 0.f, s0 + 3 <= t ? w0[3] : 0.f);
                pk.z = cvt_pk_bf16(s0 + 4 <= t ? w1[0] : 0.f, s0 + 5 <= t ? w1[1] : 0.f); pk.w = cvt_pk_bf16(s0 + 6 <= t ? w1[2] : 0.f, s0 + 7 <= t ? w1[3] : 0.f);
                const bf16x8 af = __builtin_bit_cast(bf16x8, pk);
#pragma unroll
                for (int cb = 0; cb < 2; ++cb) acc[tb][cb] = MFMA32(af, bfr[cb], acc[tb][cb]);
            }
        }
    }
    const float* bs = c.a.in[12] + (size_t)(c.layer * 4 + g) * 128;
#pragma unroll
    for (int tb = 0; tb < 4; ++tb)
#pragma unroll
        for (int r = 0; r < 16; ++r) {
            const int t = 32 * tb + crow(r, lh); const float bt = bs[t];
            bf16_t* gp = H + (row0 + t) * LDH + GUO + g * 128 + ch * 64 + l31;
#pragma unroll
            for (int cb = 0; cb < 2; ++cb) gp[32 * cb] = f2bf(bf2f(gp[32 * cb]) * (acc[tb][cb][r] + bt));
        }
    __syncthreads();
}

DI void gmlp_sample_item(const Ctx& c, int b, int lane) {
    asm volatile("" : "+v"(lane));
    bf16_t* H = Hp(c);
    const size_t r0 = (size_t)MP + (size_t)b * 8;
    const float* lg = c.a.in[9] + c.layer * 512; const float* lb = c.a.in[10] + c.layer * 512;
    float vn[8][8];
#pragma unroll
    for (int s = 0; s < 8; ++s) {
        const bf16_t* src = H + (r0 + s) * LDH + GVO;
        float sm = 0.f;
#pragma unroll
        for (int e = 0; e < 8; ++e) { vn[s][e] = bf2f(src[lane + 64 * e]); sm += vn[s][e]; }
        const float mean = wave_sum(sm) * (1.f / 512.f); float s2 = 0.f;
#pragma unroll
        for (int e = 0; e < 8; ++e) { vn[s][e] -= mean; s2 += vn[s][e] * vn[s][e]; }
        const float rstd = 1.f / sqrtf(wave_sum(s2) * (1.f / 512.f) + LN_EPS);
        float* go = c.out + O_GVS + ((size_t)(c.layer * DB + b) * 8 + s) * 512;
#pragma unroll
        for (int e = 0; e < 8; ++e) { vn[s][e] = vn[s][e] * rstd * lg[lane + 64 * e] + lb[lane + 64 * e]; go[lane + 64 * e] = vn[s][e]; }
    }
#pragma unroll
    for (int t = 0; t < 8; ++t) {
        bf16_t* gp = H + (r0 + t) * LDH + GUO;
#pragma unroll
        for (int e = 0; e < 8; ++e) {
            const int g = e >> 1;
            const float* Ws = c.a.in[11] + ((size_t)(c.layer * 4 + g) * 128 + t) * 128;
            float a = c.a.in[12][(c.layer * 4 + g) * 128 + t];
#pragma unroll
            for (int s = 0; s < 8; ++s) if (s <= t) a += Ws[s] * vn[s][e];
            gp[lane + 64 * e] = f2bf(bf2f(gp[lane + 64 * e]) * a);
        }
    }
}

DI void phase_mixer(const Ctx& c, LAS unsigned char* lds, int tid) {
    const int wave = tid >> 6, lane = tid & 63;
    for (int it = c.bid; it < 1024; it += c.G) attn_prompt_item(c, lds, it, tid);
    for (int it = c.bid; it < 256; it += c.G) gmlp_prompt_item(c, lds, it, tid);
    __syncthreads();
    for (int it = c.bid * 8 + wave; it < 1024 + 128; it += c.G * 8) {
        if (it < 1024) attn_sample_item(c, lds + wave * 8192, it, lane);
        else gmlp_sample_item(c, it - 1024, lane);
    }
    bf16_t* H = Hp(c);
    const int gt = c.bid * 512 + tid, GT = c.G * 512;
    {
        const int c0 = (gt & 63) * 8;
        const float* mw = c.a.in[13] + (size_t)c.layer * 3 * 512 + c0;
        float w0[8], w1[8], w2[8];
#pragma unroll
        for (int e = 0; e < 8; ++e) { w0[e] = mw[e]; w1[e] = mw[512 + e]; w2[e] = mw[1024 + e]; }
#pragma unroll 1
        for (int run = gt >> 6; run < MT / 8; run += GT >> 6) {
            const int row0 = run * 8; const bool samp = row0 >= MP;
            int t0, b; if (!samp) { t0 = row0 & (SEQ - 1); b = row0 >> 11; } else { t0 = 0; b = (row0 - MP) >> 3; }
            float z0[8], z1[8];
            if (samp) { const float* st = c.a.in[4] + ((size_t)(c.layer * DB + b) * 2) * 512 + c0;
#pragma unroll
                for (int e = 0; e < 8; ++e) { z0[e] = st[e]; z1[e] = st[512 + e]; } }
            else if (t0 == 0) {
#pragma unroll
                for (int e = 0; e < 8; ++e) { z0[e] = 0.f; z1[e] = 0.f; } }
            else { const bf16_t* hp = H + (size_t)(row0 - 2) * LDH;
                const u32x4 a0 = *(const u32x4*)(hp + SCO + c0), d0 = *(const u32x4*)(hp + SHO + c0), a1 = *(const u32x4*)(hp + LDH + SCO + c0), d1 = *(const u32x4*)(hp + LDH + SHO + c0);
                z0[0] = bf_lo(a0.x) * bf_lo(d0.x); z0[1] = bf_hi(a0.x) * bf_hi(d0.x); z0[2] = bf_lo(a0.y) * bf_lo(d0.y); z0[3] = bf_hi(a0.y) * bf_hi(d0.y);
                z0[4] = bf_lo(a0.z) * bf_lo(d0.z); z0[5] = bf_hi(a0.z) * bf_hi(d0.z); z0[6] = bf_lo(a0.w) * bf_lo(d0.w); z0[7] = bf_hi(a0.w) * bf_hi(d0.w);
                z1[0] = bf_lo(a1.x) * bf_lo(d1.x); z1[1] = bf_hi(a1.x) * bf_hi(d1.x); z1[2] = bf_lo(a1.y) * bf_lo(d1.y); z1[3] = bf_hi(a1.y) * bf_hi(d1.y);
                z1[4] = bf_lo(a1.z) * bf_lo(d1.z); z1[5] = bf_hi(a1.z) * bf_hi(d1.z); z1[6] = bf_lo(a1.w) * bf_lo(d1.w); z1[7] = bf_hi(a1.w) * bf_hi(d1.w); }
            u32x4 av[8], dv[8], sv[8];
#pragma unroll
            for (int r = 0; r < 8; ++r) { const bf16_t* hr = H + (size_t)(row0 + r) * LDH; av[r] = *(const u32x4*)(hr + SCO + c0); dv[r] = *(const u32x4*)(hr + SHO + c0); sv[r] = *(const u32x4*)(hr + SBO + c0); }
#pragma unroll
            for (int r = 0; r < 8; ++r) {
                float z2[8];
                z2[0] = bf_lo(av[r].x) * bf_lo(dv[r].x); z2[1] = bf_hi(av[r].x) * bf_hi(dv[r].x); z2[2] = bf_lo(av[r].y) * bf_lo(dv[r].y); z2[3] = bf_hi(av[r].y) * bf_hi(dv[r].y);
                z2[4] = bf_lo(av[r].z) * bf_lo(dv[r].z); z2[5] = bf_hi(av[r].z) * bf_hi(dv[r].z); z2[6] = bf_lo(av[r].w) * bf_lo(dv[r].w); z2[7] = bf_hi(av[r].w) * bf_hi(dv[r].w);
                const float sbf[8] = {bf_lo(sv[r].x), bf_hi(sv[r].x), bf_lo(sv[r].y), bf_hi(sv[r].y), bf_lo(sv[r].z), bf_hi(sv[r].z), bf_lo(sv[r].w), bf_hi(sv[r].w)};
                float o[8];
#pragma unroll
                for (int e = 0; e < 8; ++e) o[e] = sbf[e] * (w0[e] * z0[e] + w1[e] * z1[e] + w2[e] * z2[e]);
                u32x4 w; w.x = cvt_pk_bf16(o[0], o[1]); w.y = cvt_pk_bf16(o[2], o[3]); w.z = cvt_pk_bf16(o[4], o[5]); w.w = cvt_pk_bf16(o[6], o[7]);
                *(u32x4*)(H + (size_t)(row0 + r) * LDH + SBO + c0) = w;
                const int t = t0 + r; const int tl = samp ? DS : SEQ;
                if (t >= tl - 2) {
                    float* dst = c.out + (samp ? O_MCS + ((size_t)(c.layer * DB + b) * 2 + (t - (tl - 2))) * 512 : O_MCP + ((size_t)(c.layer * NB + b) * 2 + (t - (tl - 2))) * 512) + c0;
                    *(f32x4*)dst = (f32x4){z2[0], z2[1], z2[2], z2[3]}; *(f32x4*)(dst + 4) = (f32x4){z2[4], z2[5], z2[6], z2[7]};
                }
#pragma unroll
                for (int e = 0; e < 8; ++e) { z0[e] = z1[e]; z1[e] = z2[e]; }
            }
        }
    }
}

DI void phase_dbg(const Ctx& c, int tid) {
    const bf16_t* H = Hp(c);
#pragma unroll 1
    for (int it = c.bid * 512 + tid; it < MT * DM; it += c.G * 512) { const int row = it >> 10, col = it & 1023; c.out[it] = bf2f(H[(size_t)row * LDH + MGO + col]); }
}

DI void phase_windows(const Ctx& c, int gt, int GT) {
    bf16_t* H = Hp(c);
#pragma unroll 1
    for (int it = gt; it < NB * 128 * 32; it += GT) {
        const int cc = (it & 31) * 4, j = (it >> 5) & 127, b = it >> 12;
        const bf16_t* hr = H + ((size_t)b * SEQ + 1920 + j) * LDH;
        const u32x2 kq = *(const u32x2*)(hr + KO + cc), vq = *(const u32x2*)(hr + VO + cc);
        *(f32x4*)(c.out + O_KP + (size_t)c.layer * NB * 16384 + (size_t)it * 4) = (f32x4){bf_lo(kq.x), bf_hi(kq.x), bf_lo(kq.y), bf_hi(kq.y)};
        *(f32x4*)(c.out + O_VP + (size_t)c.layer * NB * 16384 + (size_t)it * 4) = (f32x4){bf_lo(vq.x), bf_hi(vq.x), bf_lo(vq.y), bf_hi(vq.y)};
    }
#pragma unroll 1
    for (int it = gt; it < DB * 128 * 32; it += GT) {
        const int cc = (it & 31) * 4, j = (it >> 5) & 127, b = it >> 12;
        f32x4 kv, vv;
        if (j < 120) { const size_t o = ((size_t)(c.layer * DB + b) * 128 + j + 8) * 128 + cc; kv = *(const f32x4*)(c.a.in[2] + o); vv = *(const f32x4*)(c.a.in[3] + o); }
        else { const bf16_t* hr = H + ((size_t)MP + b * 8 + (j - 120)) * LDH; const u32x2 kq = *(const u32x2*)(hr + KO + cc), vq = *(const u32x2*)(hr + VO + cc);
            kv = (f32x4){bf_lo(kq.x), bf_hi(kq.x), bf_lo(kq.y), bf_hi(kq.y)}; vv = (f32x4){bf_lo(vq.x), bf_hi(vq.x), bf_lo(vq.y), bf_hi(vq.y)}; }
        *(f32x4*)(c.out + O_KS + (size_t)c.layer * DB * 16384 + (size_t)it * 4) = kv;
        *(f32x4*)(c.out + O_VS + (size_t)c.layer * DB * 16384 + (size_t)it * 4) = vv;
    }
}
#define XB_TMO      128
#define XB_XCNT(j)  (256  + 64 * (j))
#define XB_XSUB(j)  (1280 + 64 * (j))
#define XB_XGEN(j)  (2304 + 64 * (j))
#define XB_TOP      3328
#define XB_TOPGEN   3392
#define XCD_BAR_WORDS 3456
#define XB_SPIN_CAP (1u << 18)
DI unsigned xb_ld(unsigned* p)              { return __hip_atomic_load(p, __ATOMIC_RELAXED, __HIP_MEMORY_SCOPE_AGENT); }
DI unsigned xb_add(unsigned* p, unsigned v) { return __hip_atomic_fetch_add(p, v, __ATOMIC_RELAXED, __HIP_MEMORY_SCOPE_AGENT); }
DI unsigned xb_xcc_id() { return (unsigned)__builtin_amdgcn_s_getreg((3 << 11) | 20) & 0xFu; }
#define XB_SPIN(cond, bar) do { unsigned _sp = 0; while (cond) { __builtin_amdgcn_s_sleep(1); \
    if ((++_sp & 255u) == 0u) { if (xb_ld(&(bar)[XB_TMO])) break; if (_sp > XB_SPIN_CAP) { atomicAdd(&(bar)[XB_TMO], 1u); break; } } } } while (0)
struct XcdBarrier { unsigned* bar; unsigned x; volatile LAS unsigned* st; };
DI XcdBarrier xcd_barrier_post(unsigned* bar, volatile LAS unsigned* st) {
    XcdBarrier b; b.bar = bar; b.x = xb_xcc_id(); b.st = st;
    if (threadIdx.x == 0) (void)xb_add(&bar[XB_XCNT(b.x)], 1u);
    return b;
}
DI void xcd_barrier_complete(unsigned* bar, unsigned x, unsigned& nloc, unsigned& nx) {
    const unsigned G = gridDim.x * gridDim.y * gridDim.z;
    unsigned sum, cnt, mine, sp = 0u;
    for (;;) {
        sum = 0u; cnt = 0u; mine = 0u;
#pragma unroll
        for (unsigned j = 0; j < 16; ++j) { const unsigned c = xb_ld(&bar[XB_XCNT(j)]); sum += c; cnt += (c > 0u) ? 1u : 0u; mine = (j == x) ? c : mine; }
        if (sum == G) break;
        __builtin_amdgcn_s_sleep(1);
        if ((++sp & 255u) == 0u) { if (xb_ld(&bar[XB_TMO])) break; if (sp > XB_SPIN_CAP) { atomicAdd(&bar[XB_TMO], 1u); break; } }
    }
    nloc = mine > 0u ? mine : 1u; nx = cnt > 0u ? cnt : 1u;
}
DI void xcd_barrier(const XcdBarrier& b, bool leader) {
    asm volatile("s_waitcnt vmcnt(0)" ::: "memory");
    __syncthreads();
    if (leader) {
        unsigned* bar = b.bar;
        __builtin_amdgcn_s_waitcnt(0);
        unsigned nloc = b.st[0], nx = b.st[1];
        if (nloc == 0u) { xcd_barrier_complete(bar, b.x, nloc, nx); b.st[0] = nloc; b.st[1] = nx; }
        const unsigned old = xb_add(&bar[XB_XSUB(b.x)], 1u);
        const unsigned gen = old / nloc;
        if (old + 1u == (gen + 1u) * nloc) {
            __builtin_amdgcn_fence(__ATOMIC_RELEASE, "agent");
            asm volatile("s_waitcnt vmcnt(0)" ::: "memory");
            const unsigned og = xb_add(&bar[XB_TOP], 1u);
            const unsigned tg = og / nx;
            if (og + 1u == (tg + 1u) * nx) xb_add(&bar[XB_TOPGEN], 1u);
            else XB_SPIN(xb_ld(&bar[XB_TOPGEN]) == tg, bar);
            __builtin_amdgcn_fence(__ATOMIC_ACQUIRE, "agent");
            xb_add(&bar[XB_XGEN(b.x)], 1u);
            asm volatile("s_waitcnt vmcnt(0)" ::: "memory");
        } else {
            XB_SPIN(xb_ld(&bar[XB_XGEN(b.x)]) == gen, bar);
            __builtin_amdgcn_fence(__ATOMIC_ACQUIRE, "agent");
            asm volatile("s_waitcnt vmcnt(0)" ::: "memory");
        }
    }
    __syncthreads();
}
#ifndef REPMASK
#define REPMASK 0
#endif
DI int lane_id_fresh() { int l; asm volatile("v_mbcnt_lo_u32_b32 %0, -1, 0\n\tv_mbcnt_hi_u32_b32 %0, -1, %0" : "=v"(l)); return l; }
__global__ void __launch_bounds__(512, 2) fwd_kernel(Args args) {
    extern __shared__ __attribute__((aligned(16))) unsigned char smem[];
    LAS unsigned char* lds = (LAS unsigned char*)smem;
    cg::grid_group grid = cg::this_grid();
    int layer_s = 0;
    volatile LAS unsigned* xst = (volatile LAS unsigned*)(lds + LDS_BYTES - 64);
    if (threadIdx.x < 16) xst[threadIdx.x] = 0u;
    __syncthreads();
    const int wave_s = __builtin_amdgcn_readfirstlane((int)threadIdx.x >> 6);
    const XcdBarrier xbar = xcd_barrier_post((unsigned*)args.ws, xst);
#define SEAM_CG() do { asm volatile("s_waitcnt vmcnt(0) lgkmcnt(0)" ::: "memory");     \
        grid.sync(); \
        asm volatile("s_waitcnt vmcnt(0)" ::: "memory");                \
        __syncthreads(); } while (0)
#define SEAM() xcd_barrier(xbar, wave_s == 0 && lane_id_fresh() == 0)
#define RUN(...) { int tid = wave_s * 64 + lane_id_fresh(); \
        int g_ = (int)gridDim.x, b_ = (int)blockIdx.x, l_ = layer_s; unsigned char* w_ = args.ws; float* o_ = args.out; \
        asm volatile("" : "+s"(g_), "+s"(b_), "+s"(l_), "+s"(w_), "+s"(o_));     \
        const Ctx c{args, w_, o_, g_, b_, l_}; __VA_ARGS__; }
    RUN(phase_prologue(c, lds, tid)); SEAM_CG();
    for (int l = 0; l < 2; ++l) {
        layer_s = l;
        RUN({ PhIn p{c}; g8::run(lds, p, tid); }); SEAM();
        RUN(phase_mixer(c, lds, tid)); SEAM();
        RUN({ PhMerge p{c}; g8::run(lds, p, tid);
              { const int full = 528 / c.G, tail = 528 - full * c.G, busy = (2 * tail <= c.G && tail <= 16) ? 2 * tail : tail;
                if (c.bid >= busy) { phase_windows(c, (c.bid - busy) * 512 + tid, (c.G - busy) * 512);
                    if (l == 0) convert_layer_weights(c, 0, (LAS float*)(lds + (tid >> 6) * 16384), (c.bid - busy) * 8 + (tid >> 6), (c.G - busy) * 8, tid & 63, CW_A, CW_B); } } });
        SEAM();
        RUN({ PhRes p{c, 0}; g8::run(lds, p, tid);
              if (l == 0) { const int full = 528 / c.G, tail = 528 - full * c.G, busy = (2 * tail <= c.G && tail <= 16) ? 2 * tail : tail;
                  const int vcu = (c.G & 7) == 0 ? (c.bid & 7) * (c.G >> 3) + (c.bid >> 3) : c.bid;
                  if (vcu >= busy) convert_layer_weights(c, 0, (LAS float*)(lds + (tid >> 6) * 16384), (vcu - busy) * 8 + (tid >> 6), (c.G - busy) * 8, tid & 63, CW_B, CW_ALL); } }); SEAM();
        RUN({ PhUp p{c}; g8::run(lds, p, tid);
              if (l == 0) {
                  const int tiles = 132 * 22, tail = tiles % c.G, idle = tail ? c.G - tail : c.G, me = tail ? c.bid - tail : c.bid;
                  if (me >= 0) convert_layer_weights(c, 1, (LAS float*)(lds + (tid >> 6) * 16384), me * 8 + (tid >> 6), idle * 8, tid & 63);
              } }); SEAM();
        RUN(phase_fixup(c, tid)); SEAM();
        RUN({ PhRes p{c, 1}; g8::run(lds, p, tid); }); SEAM();
    }
}

extern "C" void kernel_launch(void* const* d_in, const int* in_sizes, int n_in, void* d_out, int out_size, void* d_ws, size_t ws_size, hipStream_t stream) {
    static int grid = 0;
    if (grid == 0) {
        int dev = 0, cus = 0, per_cu = 0;
        if (n_in != 27 || (size_t)out_size != O_END || ws_size < WS_END) { fprintf(stderr, "kernel_launch: unexpected shapes (n_in %d out %d ws %zu)\n", n_in, out_size, ws_size); grid = -1; return; }
        (void)hipGetDevice(&dev);
        (void)hipDeviceGetAttribute(&cus, hipDeviceAttributeMultiprocessorCount, dev);
        (void)hipFuncSetAttribute((const void*)fwd_kernel, hipFuncAttributeMaxDynamicSharedMemorySize, LDS_BYTES);
        (void)hipOccupancyMaxActiveBlocksPerMultiprocessor(&per_cu, (const void*)fwd_kernel, 512, LDS_BYTES);
        if (per_cu < 1) { fprintf(stderr, "kernel_launch: occupancy query says %d blocks per CU\n", per_cu); per_cu = 1; }
        grid = cus < 256 ? cus : 256;
    }
    if (grid < 0) return;
    if (hipMemsetAsync(d_ws, 0, CTL_ZERO_BYTES, stream) != hipSuccess) { fprintf(stderr, "kernel_launch: memset failed\n"); return; }
    Args a{};
    for (int i = 0; i < 27; ++i) a.in[i] = (const float*)d_in[i];
    a.out = (float*)d_out; a.ws = (unsigned char*)d_ws;
    void* kargs[] = {&a};
    hipError_t e = hipLaunchCooperativeKernel((const void*)fwd_kernel, dim3(grid), dim3(512), kargs, LDS_BYTES, stream);
    if (e != hipSuccess) fprintf(stderr, "cooperative launch failed: %s (grid %d)\n", hipGetErrorString(e), grid);
}
```

```cpp
#include <hip/hip_runtime.h>
#include <hip/hip_cooperative_groups.h>
#include <cstdio>
#include <cstdint>
namespace cg = cooperative_groups;

#define LAS __attribute__((address_space(3)))
#define DI __device__ __forceinline__
typedef unsigned short bf16_t;
typedef short bf16x8 __attribute__((ext_vector_type(8)));
typedef float f32x4 __attribute__((ext_vector_type(4)));
typedef float f32x16 __attribute__((ext_vector_type(16)));
typedef unsigned u32x4 __attribute__((ext_vector_type(4)));
typedef unsigned u32x2 __attribute__((ext_vector_type(2)));

constexpr int MP = 32768, MS = 1024, MT = MP + MS, DM = 1024, NIN = 3328, NGATE = 3072, DFF = 2816, NUP = 5632;
constexpr int SEQ = 2048, NB = 16, DB = 128, DS = 8;
constexpr int QO = 0, KO = 512, VO = 640, GUO = 768, GVO = 1280, SBO = 1792, SCO = 2304, SHO = 2816, MGO = 2304;
constexpr int LDH = 3328;
constexpr float ALPHA = 1.41421356237309515f;
constexpr float LN_EPS = 1e-5f;
constexpr size_t W_IN = 0, W_G = W_IN + (size_t)NIN * DM, W_PA = W_G + (size_t)NGATE * DM, W_PG = W_PA + 512 * 1024, W_PC = W_PG + 512 * 1024,
                 W_O = W_PC + 512 * 1024, W_UP = W_O + 1024 * 1024, W_DN = W_UP + (size_t)NUP * DM, W_LAYER = W_DN + (size_t)DM * DFF;
constexpr size_t MiB = 1u << 20;
constexpr size_t WS_WT = 1 * MiB, WS_XB = 69 * MiB, WS_H = 135 * MiB, WS_GS = 350 * MiB, WS_HALO = 478 * MiB, WS_XBUF = 490 * MiB, WS_PART = 496 * MiB, WS_END = 500 * MiB;
constexpr size_t WS_CNT = 16384, CTL_ZERO_BYTES = 262144;
constexpr size_t XBUF_INST = (size_t)132 * 256 * 4 * 8;
constexpr size_t WS_PFLAG = WS_CNT + 4 * 132 * 256;
static_assert(WS_PFLAG + 6 * 16 * 256 <= CTL_ZERO_BYTES && WS_PART + (size_t)16 * 512 * 512 <= WS_END, "ws map 4");
static_assert(WS_CNT + 4 * 132 * 256 <= CTL_ZERO_BYTES && WS_XBUF + 4 * XBUF_INST <= WS_END, "ws map 3");
constexpr int XL_OFF = 131072;
static_assert(WS_WT + 2 * W_LAYER * 2 <= WS_XB && WS_XB + (size_t)MT * DM * 2 <= WS_H && WS_H + (size_t)MT * LDH * 2 <= WS_GS, "ws map");
static_assert(WS_GS + (size_t)MT * NGATE <= WS_HALO && WS_HALO + (size_t)132 * 4 * NUP * 4 <= WS_END, "ws map 2");
constexpr size_t O_Y = 0, O_KP = (size_t)MT * DM, O_VP = O_KP + 524288, O_MCP = O_VP + 524288, O_FCP = O_MCP + 32768, O_KS = O_FCP + 360448,
                 O_VS = O_KS + 4194304, O_MCS = O_VS + 4194304, O_FCS = O_MCS + 262144, O_GVS = O_FCS + 2883584, O_END = O_GVS + 1048576;
constexpr int LDS_BYTES = 147456;
constexpr int HL_OFF = 131072;

typedef float f32x2_t __attribute__((ext_vector_type(2)));
typedef __bf16 bf16x2_t __attribute__((ext_vector_type(2)));
DI unsigned cvt_pk_bf16(float lo, float hi) { const f32x2_t v = {lo, hi}; return __builtin_bit_cast(unsigned, __builtin_convertvector(v, bf16x2_t)); }
DI float bf_lo(unsigned u) { return __uint_as_float(u << 16); }
DI float bf_hi(unsigned u) { return __uint_as_float(u & 0xffff0000u); }
DI float bf2f(bf16_t h) { return __uint_as_float((unsigned)h << 16); }
DI bf16_t f2bf(float f) { return (bf16_t)(cvt_pk_bf16(f, 0.f) & 0xffffu); }
DI float fast_exp(float x) { return __builtin_amdgcn_exp2f(x * 1.44269504089f); }
DI float sigmoidf(float x) { x = fminf(fmaxf(x, -30.f), 30.f); return __builtin_amdgcn_rcpf(1.f + fast_exp(-x)); }
DI float wave_sum(float v) {
#pragma unroll
    for (int o = 1; o < 64; o <<= 1) v += __shfl_xor(v, o);
    return v;
}
DI float wave_max(float v) {
#pragma unroll
    for (int o = 1; o < 64; o <<= 1) v = fmaxf(v, __shfl_xor(v, o));
    return v;
}
template <int CTRL> DI float dppz(float src) {
    return __builtin_bit_cast(float, __builtin_amdgcn_update_dpp(0, __builtin_bit_cast(int, src), CTRL, 0xf, 0xf, true));
}
template <int CTRL> DI f32x4 dppz4(f32x4 s) { f32x4 r; r.x = dppz<CTRL>(s.x); r.y = dppz<CTRL>(s.y); r.z = dppz<CTRL>(s.z); r.w = dppz<CTRL>(s.w); return r; }
template <int CTRL> DI float dppo(float old, float src) {
    return __builtin_bit_cast(float, __builtin_amdgcn_update_dpp(__builtin_bit_cast(int, old), __builtin_bit_cast(int, src), CTRL, 0xf, 0xf, false));
}
template <int CTRL> DI f32x4 dppo4(f32x4 o, f32x4 s) { f32x4 r; r.x = dppo<CTRL>(o.x, s.x); r.y = dppo<CTRL>(o.y, s.y); r.z = dppo<CTRL>(o.z, s.z); r.w = dppo<CTRL>(o.w, s.w); return r; }
DI f32x4 sel4(bool c, f32x4 a, f32x4 b) { f32x4 r; r.x = c ? a.x : b.x; r.y = c ? a.y : b.y; r.z = c ? a.z : b.z; r.w = c ? a.w : b.w; return r; }

namespace g8 {
constexpr int BM = 256, BK = 64, HALF = 128, HTB = HALF * BK * 2, RING = 8 * HTB;
DI int lds_byte(int r, int c) { const int st = (r >> 4) * 2 + (c >> 5), rr = r & 15, cc = c & 31, ob = rr * 64 + cc * 2; return st * 1024 + (ob ^ (((ob >> 9) & 1) << 5)); }
DI void stage_rc(int b, int& R, int& C) { const int st = b / 1024, sb = b % 1024, swz = sb ^ (((sb >> 9) & 1) << 5); R = (st >> 1) * 16 + swz / 64; C = (st & 1) * 32 + (swz % 64) / 2; }
DI int perm32(int rho) { const int n = rho >> 4, i = rho & 15; return 8 * (i >> 2) + 4 * n + (i & 3); }

struct UnitD {
    const char* A; const char* B;
    unsigned lda, ldb;
    int nt;
    int pm, pn, sub;
    bool permA;
    int split, slot;
    bool zero, perm;
};
DI void tile_of(int L, int nM, int nN, int& pm, int& pn) {
    const int nwg = nM * nN; int wgid = L;
    { const int q = nwg / 8, r = nwg % 8, xcd = wgid % 8, off = wgid / 8; wgid = (xcd < r ? xcd * (q + 1) : r * (q + 1) + (xcd - r) * q) + off; }
    const int nig = 8 * nN, gid = wgid / nig, fm = gid * 8, gsz = (nM - fm) < 8 ? (nM - fm) : 8;
    pm = fm + ((wgid % nig) % gsz); pn = (wgid % nig) / gsz;
}

template <class P>
DI void run(LAS unsigned char* lds, const P& ph, int tid_in) {
    int tid = tid_in; asm volatile("" : "+v"(tid));
    const int wid = __builtin_amdgcn_readfirstlane(tid >> 6), lane = tid & 63, wr = wid >> 2, wc = wid & 3, fr = lane & 15, fq = lane >> 4;
    int R, C; stage_rc(tid * 16, R, C);
    const int Rp = (R & ~31) + perm32(R & 31);
    const int Ra = (R & ~63) + 4 * (R & 15) + ((R & 63) >> 4);
    const unsigned C2 = (unsigned)C * 2u;
    const unsigned ldsw = (unsigned)wid * 1024u;
    const int aoff = lds_byte(wr * 64 + fr, fq * 8), boff = lds_byte(wc * 32 + fr, fq * 8);
#define G8_SA(b, h) (((b) * 2 + (h)) * HTB)
#define G8_SB(b, h) ((4 + (b) * 2 + (h)) * HTB)
#define G8_STG(bufoff, gp, vo, ld) do { \
        __builtin_amdgcn_global_load_lds((const unsigned*)((gp) + (vo)), (LAS unsigned*)(lds + (bufoff) + ldsw), 16, 0, 0); \
        __builtin_amdgcn_global_load_lds((const unsigned*)((gp) + ((vo) + 64u * (ld))), (LAS unsigned*)(lds + (bufoff) + ldsw + 8192), 16, 0, 0); } while (0)
#define G8_LDA(dst, b, h) do { _Pragma("unroll") for (int m = 0; m < 4; ++m) _Pragma("unroll") for (int k = 0; k < 2; ++k) dst[m][k] = *(const LAS bf16x8*)(lds + G8_SA(b, h) + aoff + m * 2048 + k * 1024); } while (0)
#define G8_LDB(dst, b, h) do { _Pragma("unroll") for (int n = 0; n < 2; ++n) _Pragma("unroll") for (int k = 0; k < 2; ++k) dst[n][k] = *(const LAS bf16x8*)(lds + G8_SB(b, h) + boff + n * 2048 + k * 1024); } while (0)
#define G8_MMA(ai, bj, At, Bt) do { __builtin_amdgcn_s_setprio(1); _Pragma("unroll") for (int m = 0; m < 4; ++m) _Pragma("unroll") for (int n = 0; n < 2; ++n) _Pragma("unroll") for (int k = 0; k < 2; ++k) \
        acc[ai][bj][m][n] = __builtin_amdgcn_mfma_f32_16x16x32_bf16(Bt[n][k], At[m][k], acc[ai][bj][m][n], 0, 0, 0); __builtin_amdgcn_s_setprio(0); } while (0)
#define G8_WAIT_V(n) asm volatile("s_waitcnt vmcnt(" #n ")" ::: "memory")
#define G8_WAIT_L(n) asm volatile("s_waitcnt lgkmcnt(" #n ")" ::: "memory")
#define G8_BAR __builtin_amdgcn_s_barrier()
#define G8_SCHED __builtin_amdgcn_sched_barrier(0)
    UnitD cur, nxt; int ui = 0;
    if (!ph.get(0, cur)) return;
    f32x4 acc[2][2][4][2];
#pragma unroll
    for (int a = 0; a < 2; ++a)
#pragma unroll
        for (int b = 0; b < 2; ++b)
#pragma unroll
            for (int m = 0; m < 4; ++m)
#pragma unroll
                for (int n = 0; n < 2; ++n) acc[a][b][m][n] = (f32x4){0.f, 0.f, 0.f, 0.f};
    bf16x8 At[4][2], B0[2][2], B1[2][2];
    const char* cA = cur.A; const char* cB = cur.B;
    unsigned lda = cur.lda, ldb = cur.ldb;
    unsigned vA = (unsigned)(cur.permA ? Ra : R) * lda + C2, vB = (unsigned)(cur.perm ? Rp : R) * ldb + C2;
    {
        const unsigned hA = 128u * lda, hB = 128u * ldb;
        G8_STG(G8_SB(0, 0), cB, vB, ldb); G8_STG(G8_SB(0, 1), cB + hB, vB, ldb); G8_STG(G8_SA(0, 0), cA, vA, lda); G8_STG(G8_SA(0, 1), cA + hA, vA, lda);
        if (wr == 1) G8_BAR;
        G8_WAIT_V(2); G8_BAR;
        G8_STG(G8_SB(1, 0), cB + 128, vB, ldb); G8_STG(G8_SA(1, 0), cA + 128, vA, lda); G8_STG(G8_SB(1, 1), cB + hB + 128, vB, ldb);
        G8_WAIT_V(6); G8_BAR;
    }
    for (;;) {
        const bool has_next = ph.get(ui + 1, nxt);
        const char* nA = has_next ? nxt.A : cA; const char* nB = has_next ? nxt.B : cB;
        const unsigned nlda = has_next ? nxt.lda : lda, nldb = has_next ? nxt.ldb : ldb;
        const unsigned nvA = (unsigned)((has_next ? nxt.permA : cur.permA) ? Ra : R) * nlda + C2, nvB = (unsigned)((has_next ? nxt.perm : cur.perm) ? Rp : R) * nldb + C2;
        const int nt = cur.nt;
        for (int t = 0; t < nt; t += 2) {
            const bool last = (t == nt - 2);
            const char* a1 = cA + (size_t)(t + 1) * 128;
            const char* a2 = last ? nA : cA + (size_t)(t + 2) * 128; const char* b2 = last ? nB : cB + (size_t)(t + 2) * 128;
            const unsigned xlda = last ? nlda : lda, xldb = last ? nldb : ldb, xvA = last ? nvA : vA, xvB = last ? nvB : vB;
            const unsigned xhA = 128u * xlda, xhB = 128u * xldb;
            const char* a3 = a2 + 128; const char* b3 = b2 + 128;
            G8_LDB(B0, 0, 0); G8_LDB(B1, 0, 1); G8_SCHED; G8_LDA(At, 0, 0); G8_STG(G8_SA(1, 1), a1 + 128u * lda, vA, lda);
            G8_WAIT_V(8); G8_WAIT_L(0); G8_BAR; G8_MMA(0, 0, At, B0); G8_MMA(0, 1, At, B1); G8_BAR; G8_SCHED;
            G8_LDA(At, 0, 1); G8_STG(G8_SB(0, 0), b2, xvB, xldb); G8_STG(G8_SB(0, 1), b2 + xhB, xvB, xldb); G8_STG(G8_SA(0, 0), a2, xvA, xlda);
            G8_WAIT_V(8); G8_WAIT_L(0); G8_BAR; G8_MMA(1, 0, At, B0); G8_MMA(1, 1, At, B1); G8_BAR; G8_SCHED;
            G8_LDB(B0, 1, 0); G8_LDB(B1, 1, 1); G8_SCHED; G8_LDA(At, 1, 0); G8_STG(G8_SA(0, 1), a2 + xhA, xvA, xlda);
            G8_WAIT_V(8); G8_WAIT_L(0); G8_BAR; G8_MMA(0, 0, At, B0); G8_MMA(0, 1, At, B1); G8_BAR; G8_SCHED;
            G8_LDA(At, 1, 1); G8_STG(G8_SB(1, 0), b3, xvB, xldb); G8_STG(G8_SB(1, 1), b3 + xhB, xvB, xldb); G8_STG(G8_SA(1, 0), a3, xvA, xlda);
            G8_WAIT_V(8); G8_WAIT_L(0); G8_BAR; G8_MMA(1, 0, At, B0); G8_MMA(1, 1, At, B1); G8_BAR; G8_SCHED;
        }
        if (wr == 0) G8_BAR;
        ph.epi(acc, cur, lds, tid, wid, lane, wr, wc, fr, fq);
        if (!has_next) break;
        if (nxt.zero) {
#pragma unroll
            for (int a = 0; a < 2; ++a)
#pragma unroll
                for (int b = 0; b < 2; ++b)
#pragma unroll
                    for (int m = 0; m < 4; ++m)
#pragma unroll
                        for (int n = 0; n < 2; ++n) acc[a][b][m][n] = (f32x4){0.f, 0.f, 0.f, 0.f};
        }
        cur = nxt; cA = nA; cB = nB; lda = nlda; ldb = nldb; vA = nvA; vB = nvB; ++ui;
        if (wr == 1) G8_BAR;
    }
    G8_WAIT_V(0);
    G8_BAR;
#undef G8_SA
#undef G8_SB
#undef G8_STG
#undef G8_LDA
#undef G8_LDB
#undef G8_MMA
#undef G8_WAIT_V
#undef G8_WAIT_L
#undef G8_BAR
#undef G8_SCHED
}
}
using g8::UnitD;
typedef f32x4 Acc[2][2][4][2];

struct Args { const float* in[27]; float* out; unsigned char* ws; };
struct Ctx {
    const Args& a;
    unsigned char* ws; float* out;
    int G, bid, layer;
};
DI bf16_t* wt_ptr(const Ctx& c, size_t off) { return (bf16_t*)(c.ws + WS_WT) + (size_t)c.layer * W_LAYER + off; }
DI bf16_t* XBp(const Ctx& c) { return (bf16_t*)(c.ws + WS_XB); }
DI bf16_t* Hp(const Ctx& c) { return (bf16_t*)(c.ws + WS_H); }
DI float* XFp(const Ctx& c) { return c.out + O_Y; }
DI float* HALOp(const Ctx& c) { return (float*)(c.ws + WS_HALO); }


DI bool splitk_combine(Acc& acc, unsigned char* ws, const UnitD& u, int inst, int tid, int wid, int lane) {
    unsigned long long* buf = (unsigned long long*)(ws + WS_PART) + (size_t)u.slot * 64 * 512;
    unsigned* flag = (unsigned*)(ws + WS_PFLAG) + (inst * 16 + u.slot) * 64;
    const bool sec = (u.split == 2);
    if (!sec) {
        if (wid == 0) { unsigned sp = 0; while ((unsigned)__builtin_amdgcn_readfirstlane(__hip_atomic_load(flag, __ATOMIC_RELAXED, __HIP_MEMORY_SCOPE_AGENT)) < 8u) { __builtin_amdgcn_s_sleep(2); if (++sp > (1u << 22)) break; } }
        asm volatile("s_waitcnt vmcnt(0) lgkmcnt(0)" ::: "memory"); __builtin_amdgcn_s_barrier(); asm volatile("" ::: "memory");
    }
#pragma unroll
    for (int ai = 0; ai < 2; ++ai)
#pragma unroll
        for (int bj = 0; bj < 2; ++bj) {
            unsigned long long* p = (buf + ((ai * 2 + bj) * 16) * 512) + tid;
            if (sec) {
#pragma unroll
                for (int m = 0; m < 4; ++m)
#pragma unroll
                    for (int n = 0; n < 2; ++n) { const f32x4 v = acc[ai][bj][m][n]; const int q = (m * 2 + n) * 2;
                        __hip_atomic_store(p + q * 512, ((unsigned long long)__float_as_uint(v.y) << 32) | __float_as_uint(v.x), __ATOMIC_RELAXED, __HIP_MEMORY_SCOPE_AGENT);
                        __hip_atomic_store(p + (q + 1) * 512, ((unsigned long long)__float_as_uint(v.w) << 32) | __float_as_uint(v.z), __ATOMIC_RELAXED, __HIP_MEMORY_SCOPE_AGENT); }
            } else {
                unsigned long long w[16];
#pragma unroll
                for (int q = 0; q < 16; ++q) w[q] = __hip_atomic_load(p + q * 512, __ATOMIC_RELAXED, __HIP_MEMORY_SCOPE_AGENT);
#pragma unroll
                for (int m = 0; m < 4; ++m)
#pragma unroll
                    for (int n = 0; n < 2; ++n) { const int q = (m * 2 + n) * 2;
                        acc[ai][bj][m][n] += (f32x4){__uint_as_float((unsigned)w[q]), __uint_as_float((unsigned)(w[q] >> 32)), __uint_as_float((unsigned)w[q + 1]), __uint_as_float((unsigned)(w[q + 1] >> 32))}; }
            }
            asm volatile("" ::: "memory");
        }
    if (sec) {
        asm volatile("s_waitcnt vmcnt(0)" ::: "memory");
        if (lane == 0) __hip_atomic_fetch_add(flag, 1u, __ATOMIC_RELAXED, __HIP_MEMORY_SCOPE_AGENT);
    }
    return sec;
}

DI void store_tile_bf16_perm(const Acc& acc, bf16_t* base  , size_t ld, int wr, int wc, int fr, int fq) {
#pragma unroll
    for (int ai = 0; ai < 2; ++ai)
#pragma unroll
        for (int m = 0; m < 4; ++m) {
            bf16_t* rowp = base + (size_t)(ai * 128 + wr * 64 + m * 16 + fr) * ld + wc * 32 + 8 * fq;
#pragma unroll
            for (int bj = 0; bj < 2; ++bj) {
                const f32x4 v0 = acc[ai][bj][m][0], v1 = acc[ai][bj][m][1];
                u32x4 w; w.x = cvt_pk_bf16(v0[0], v0[1]); w.y = cvt_pk_bf16(v0[2], v0[3]); w.z = cvt_pk_bf16(v1[0], v1[1]); w.w = cvt_pk_bf16(v1[2], v1[3]);
                *(u32x4*)(rowp + bj * 128) = w;
            }
        }
}

struct PhIn {
    Ctx c;
    DI bool get(int i, UnitD& u) const {
        const long L = (long)i * c.G + c.bid; if (L >= 132 * 25) return false;
        int pm, pn; g8::tile_of((int)L, 132, 25, pm, pn);
        u.A = (const char*)(XBp(c) + (size_t)pm * 256 * DM); u.B = (const char*)(wt_ptr(c, W_IN) + (size_t)pn * 256 * DM);
        u.lda = DM * 2; u.ldb = DM * 2; u.nt = DM / 64; u.pm = pm; u.pn = pn; u.sub = 0; u.split = 0; u.slot = 0; u.permA = false; u.zero = true; u.perm = true; return true;
    }
    DI void epi(Acc& acc, const UnitD& u, LAS unsigned char* lds, int tid, int wid, int lane, int wr, int wc, int fr, int fq) const {
        asm volatile("" : "+v"(fr), "+v"(fq), "+v"(tid));
        const bool isG = u.pn >= 13;
        const int gc = (isG ? (u.pn - 13) * 256 : 0) + wc * 32 + 8 * fq;
        const float* bg = c.a.in[8] + (size_t)c.layer * NGATE + gc;
        unsigned char* gbase = c.ws + WS_GS + (size_t)u.pm * 256 * NGATE + gc;
        bf16_t* hbase = Hp(c) + (size_t)u.pm * 256 * LDH + (isG ? 0 : u.pn * 256) + wc * 32 + 8 * fq;
#pragma unroll
        for (int ai = 0; ai < 2; ++ai)
#pragma unroll
            for (int m = 0; m < 4; ++m) {
                const int row = ai * 128 + wr * 64 + m * 16 + fr;
#pragma unroll
                for (int bj = 0; bj < 2; ++bj) {
                    f32x4 v0 = acc[ai][bj][m][0], v1 = acc[ai][bj][m][1];
                    if (isG) {
                        const f32x4 nb0 = *(const f32x4*)(bg + bj * 128) * -1.44269504089f, nb1 = *(const f32x4*)(bg + bj * 128 + 4) * -1.44269504089f;
                        unsigned q[8];
#pragma unroll
                        for (int e = 0; e < 4; ++e) {
                            const float t0 = __builtin_amdgcn_exp2f(__builtin_fmaf(v0[e], -1.44269504089f, nb0[e])), t1 = __builtin_amdgcn_exp2f(__builtin_fmaf(v1[e], -1.44269504089f, nb1[e]));
                            const unsigned a0 = (unsigned)__builtin_fmaf(__builtin_amdgcn_rcpf(1.f + t0), 255.f, 0.5f), a1 = (unsigned)__builtin_fmaf(__builtin_amdgcn_rcpf(1.f + t1), 255.f, 0.5f);
                            q[e] = a0 > 1u ? a0 : 1u; q[4 + e] = a1 > 1u ? a1 : 1u;
                        }
                        u32x2 w; w.x = q[0] | (q[1] << 8) | (q[2] << 16) | (q[3] << 24); w.y = q[4] | (q[5] << 8) | (q[6] << 16) | (q[7] << 24);
                        *(u32x2*)(gbase + (size_t)row * NGATE + bj * 128) = w;
                    } else {
                        u32x4 w; w.x = cvt_pk_bf16(v0[0], v0[1]); w.y = cvt_pk_bf16(v0[2], v0[3]); w.z = cvt_pk_bf16(v1[0], v1[1]); w.w = cvt_pk_bf16(v1[2], v1[3]);
                        *(u32x4*)(hbase + (size_t)row * LDH + bj * 128) = w;
                    }
                }
            }
    }
};

struct PhMerge {
    Ctx c;
    DI bool get(int i, UnitD& u) const {
        const int ti = i / 3, j = i - ti * 3;
        const int full = 528 / c.G, tail = 528 - full * c.G;
        int L, kh = 0; u.split = 0; u.slot = 0; u.permA = false;
        if (ti < full) L = ti * c.G + c.bid;
        else if (ti == full && 2 * tail <= c.G && tail <= 16) { if (c.bid >= 2 * tail) return false; L = full * c.G + (c.bid >> 1); kh = c.bid & 1; u.split = 1 + kh; u.slot = c.bid >> 1; }
        else if (ti == full) { L = ti * c.G + c.bid; if (L >= 528) return false; }
        else return false;
        int pm, pn; g8::tile_of(L, 132, 4, pm, pn);
        u.pm = pm; u.pn = pn; u.sub = j; u.perm = true;
        const int co = j == 0 ? QO : (j == 1 ? GUO : SBO);
        const int kn = u.split ? 256 : 512;
        u.A = (const char*)(Hp(c) + (size_t)pm * 256 * LDH + co + kh * kn); u.B = (const char*)(wt_ptr(c, W_PA) + (size_t)j * 512 * 1024 + (size_t)pn * 256 * 512 + kh * kn);
        u.lda = LDH * 2; u.ldb = 512 * 2; u.nt = kn / 64; u.zero = (j == 0);
        return true;
    }
    DI void epi(Acc& acc, const UnitD& u, LAS unsigned char* lds, int tid, int wid, int lane, int wr, int wc, int fr, int fq) const {
        asm volatile("" : "+v"(fr), "+v"(fq), "+v"(tid));
        const int j = u.sub; const bool lastj = (j == 2);
        const unsigned char* gp = c.ws + WS_GS + (size_t)(u.pm * 256 + wr * 64 + fr) * NGATE + j * 1024 + u.pn * 256 + wc * 32 + 8 * fq;
        u32x2 qa[16], qb[16];
#pragma unroll
        for (int ai = 0; ai < 2; ++ai)
#pragma unroll
            for (int m = 0; m < 4; ++m)
#pragma unroll
                for (int bj = 0; bj < 2; ++bj) {
                    const int k = (ai * 4 + m) * 2 + bj;
                    const unsigned char* p = gp + (size_t)(ai * 128 + m * 16) * NGATE + bj * 128;
                    qa[k] = *(const u32x2*)p;
                    qb[k] = (u32x2){0xffffffffu, 0xffffffffu};
                    if (!lastj) qb[k] = *(const u32x2*)(p + 1024);
                }
        asm volatile("" ::: "memory");
#pragma unroll
        for (int ai = 0; ai < 2; ++ai)
#pragma unroll
            for (int m = 0; m < 4; ++m)
#pragma unroll
                for (int bj = 0; bj < 2; ++bj) {
                    const int k = (ai * 4 + m) * 2 + bj;
                    const u32x2 a = qa[k], b = qb[k];
                    f32x4 s0, s1;
                    s0[0] = (float)(a.x & 0xff) * __builtin_amdgcn_rcpf((float)(b.x & 0xff)); s0[1] = (float)((a.x >> 8) & 0xff) * __builtin_amdgcn_rcpf((float)((b.x >> 8) & 0xff));
                    s0[2] = (float)((a.x >> 16) & 0xff) * __builtin_amdgcn_rcpf((float)((b.x >> 16) & 0xff)); s0[3] = (float)(a.x >> 24) * __builtin_amdgcn_rcpf((float)(b.x >> 24));
                    s1[0] = (float)(a.y & 0xff) * __builtin_amdgcn_rcpf((float)(b.y & 0xff)); s1[1] = (float)((a.y >> 8) & 0xff) * __builtin_amdgcn_rcpf((float)((b.y >> 8) & 0xff));
                    s1[2] = (float)((a.y >> 16) & 0xff) * __builtin_amdgcn_rcpf((float)((b.y >> 16) & 0xff)); s1[3] = (float)(a.y >> 24) * __builtin_amdgcn_rcpf((float)(b.y >> 24));
                    acc[ai][bj][m][0] *= s0; acc[ai][bj][m][1] *= s1;
                }
        if (lastj) {
            if (u.split && splitk_combine(acc, c.ws, u, c.layer * 3 + 0, tid, wid, lane)) return;
            store_tile_bf16_perm(acc, Hp(c) + (size_t)u.pm * 256 * LDH + MGO + u.pn * 256, LDH, wr, wc, fr, fq);
        }
    }
};

typedef float f32x2v __attribute__((ext_vector_type(2)));
struct PhRes {
    Ctx c; int which;
    DI bool get(int i, UnitD& u) const {
        const int vcu = (c.G & 7) == 0 ? (c.bid & 7) * (c.G >> 3) + (c.bid >> 3) : c.bid;
        const int full = 528 / c.G, tail = 528 - full * c.G;
        int L, kh = 0; u.split = 0; u.slot = 0; u.permA = false;
        if (i < full) L = i * c.G + vcu;
        else if (i == full && 2 * tail <= c.G && tail <= 16) { if (vcu >= 2 * tail) return false; L = full * c.G + (vcu >> 1); kh = vcu & 1; u.split = 1 + kh; u.slot = vcu >> 1; }
        else if (i == full) { L = i * c.G + vcu; if (L >= 528) return false; }
        else return false;
        const int pm = L >> 2, pn = L & 3;
        u.pm = pm; u.pn = pn; u.sub = 0; u.zero = true; u.perm = true;
        if (which == 0) { const int kn = u.split ? 512 : 1024; u.A = (const char*)(Hp(c) + (size_t)pm * 256 * LDH + MGO + kh * kn); u.lda = LDH * 2; u.B = (const char*)(wt_ptr(c, W_O) + (size_t)pn * 256 * 1024 + kh * kn); u.ldb = 1024 * 2; u.nt = kn / 64; }
        else { const int kn = u.split ? DFF / 2 : DFF; u.A = (const char*)(Hp(c) + (size_t)pm * 256 * DFF + kh * kn); u.lda = DFF * 2; u.B = (const char*)(wt_ptr(c, W_DN) + (size_t)pn * 256 * DFF + kh * kn); u.ldb = DFF * 2; u.nt = kn / 64; }
        return true;
    }
    DI void epi(Acc& acc, const UnitD& u, LAS unsigned char* lds, int tid, int wid, int lane, int wr, int wc, int fr, int fq) const {
        asm volatile("" : "+v"(fr), "+v"(fq), "+v"(tid), "+v"(lane));
        if (u.split && splitk_combine(acc, c.ws, u, c.layer * 3 + 1 + which, tid, wid, lane)) return;
        float* outp = XFp(c) + (size_t)u.pm * 256 * DM;
        bf16_t* outb = XBp(c) + (size_t)u.pm * 256 * DM;
        const bool final_out = (which == 1 && c.layer == 1);
        const int col0 = u.pn * 256 + wc * 32 + 8 * fq;
        const unsigned loff = (unsigned)((wr * 64 + fr) * DM + col0);
#pragma unroll
        for (int ai = 0; ai < 2; ++ai) {
            u32x4 r[4][2];
#pragma unroll
            for (int m = 0; m < 4; ++m)
#pragma unroll
                for (int bj = 0; bj < 2; ++bj) r[m][bj] = *(const u32x4*)((outb + ((ai * 128 + m * 16) * DM + bj * 128)) + loff);
            asm volatile("" ::: "memory");
#pragma unroll
            for (int m = 0; m < 4; ++m)
#pragma unroll
                for (int bj = 0; bj < 2; ++bj) { const u32x4 w = r[m][bj];
                    acc[ai][bj][m][0] = (f32x4){bf_lo(w.x), bf_hi(w.x), bf_lo(w.y), bf_hi(w.y)} * ALPHA + acc[ai][bj][m][0];
                    acc[ai][bj][m][1] = (f32x4){bf_lo(w.z), bf_hi(w.z), bf_lo(w.w), bf_hi(w.w)} * ALPHA + acc[ai][bj][m][1]; }
            asm volatile("" ::: "memory");
        }
        const float* lg = c.a.in[which == 0 ? 19 : 25] + c.layer * DM + col0; const float* lb = c.a.in[which == 0 ? 20 : 26] + c.layer * DM + col0;
        f32x4 g4[2][2], b4[2][2];
#pragma unroll
        for (int bj = 0; bj < 2; ++bj)
#pragma unroll
            for (int n = 0; n < 2; ++n) { g4[bj][n] = *(const f32x4*)(lg + bj * 128 + n * 4); b4[bj][n] = *(const f32x4*)(lb + bj * 128 + n * 4); }
        LAS f32x2v* P = (LAS f32x2v*)(lds + XL_OFF);
        LAS f32x2v* S = (LAS f32x2v*)(lds + XL_OFF + 8192);
        const int inst = c.layer * 2 + which;
        unsigned long long* xbuf = (unsigned long long*)(c.ws + WS_XBUF + (size_t)inst * XBUF_INST);
        unsigned* cnt = (unsigned*)(c.ws + WS_CNT) + ((size_t)inst * 132 + u.pm) * 64;
#pragma unroll
        for (int ai = 0; ai < 2; ++ai)
#pragma unroll
            for (int m = 0; m < 4; ++m) {
                float sm = 0.f;
#pragma unroll
                for (int bj = 0; bj < 2; ++bj)
#pragma unroll
                    for (int n = 0; n < 2; ++n) { const f32x4 x = acc[ai][bj][m][n]; sm += (x[0] + x[1]) + (x[2] + x[3]); }
                sm += __shfl_xor(sm, 16); sm += __shfl_xor(sm, 32);
                const float mw = sm * (1.0f / 64.0f); float q = 0.f;
#pragma unroll
                for (int bj = 0; bj < 2; ++bj)
#pragma unroll
                    for (int n = 0; n < 2; ++n) { const f32x4 d = acc[ai][bj][m][n] - mw; q += (d[0] * d[0] + d[1] * d[1]) + (d[2] * d[2] + d[3] * d[3]); }
                q += __shfl_xor(q, 16); q += __shfl_xor(q, 32);
                P[(ai * 128 + wr * 64 + m * 16 + fr) * 4 + wc] = (f32x2v){mw, q};
            }
        asm volatile("s_waitcnt lgkmcnt(0)" ::: "memory"); __builtin_amdgcn_s_barrier(); asm volatile("" ::: "memory");
        const int prow = wid * 32 + (lane & 31);
        if (lane < 32) {
            const f32x2v a = P[prow * 4 + 0], b = P[prow * 4 + 1], cc = P[prow * 4 + 2], d = P[prow * 4 + 3];
            const float mt = (a.x + b.x + cc.x + d.x) * 0.25f;
            const float da = a.x - mt, db = b.x - mt, dc = cc.x - mt, dd = d.x - mt;
            const float m2 = (a.y + b.y) + (cc.y + d.y) + 64.0f * ((da * da + db * db) + (dc * dc + dd * dd));
            __hip_atomic_store(xbuf + ((size_t)(u.pm * 256 + prow) * 4 + u.pn), ((unsigned long long)__float_as_uint(m2) << 32) | __float_as_uint(mt), __ATOMIC_RELAXED, __HIP_MEMORY_SCOPE_AGENT);
        }
        asm volatile("s_waitcnt vmcnt(0)" ::: "memory");
        if (lane == 0) __hip_atomic_fetch_add(cnt, 1u, __ATOMIC_RELAXED, __HIP_MEMORY_SCOPE_AGENT);
        if (wid == 0) {
            unsigned sp = 0;
            while ((unsigned)__builtin_amdgcn_readfirstlane(__hip_atomic_load(cnt, __ATOMIC_RELAXED, __HIP_MEMORY_SCOPE_AGENT)) < 32u) { __builtin_amdgcn_s_sleep(2); if (++sp > (1u << 22)) break; }
        }
        asm volatile("s_waitcnt vmcnt(0) lgkmcnt(0)" ::: "memory"); __builtin_amdgcn_s_barrier(); asm volatile("" ::: "memory");
        if (lane < 32) {
            const unsigned long long* slot = xbuf + (size_t)(u.pm * 256 + prow) * 4;
            float mt[4], m2[4]; float ms = 0.f;
#pragma unroll
            for (int t = 0; t < 4; ++t) { const unsigned long long w = __hip_atomic_load(slot + t, __ATOMIC_RELAXED, __HIP_MEMORY_SCOPE_AGENT); mt[t] = __uint_as_float((unsigned)w); m2[t] = __uint_as_float((unsigned)(w >> 32)); ms += mt[t]; }
            const float mean = ms * 0.25f; float q = 0.f;
#pragma unroll
            for (int t = 0; t < 4; ++t) { const float dm = mt[t] - mean; q += m2[t] + 256.0f * dm * dm; }
            S[prow] = (f32x2v){mean, 1.0f / sqrtf(q * (1.0f / 1024.0f) + LN_EPS)};
        }
        asm volatile("s_waitcnt lgkmcnt(0)" ::: "memory"); __builtin_amdgcn_s_barrier(); asm volatile("" ::: "memory");
#pragma unroll
        for (int ai = 0; ai < 2; ++ai)
#pragma unroll
            for (int m = 0; m < 4; ++m) {
                const int r = ai * 128 + wr * 64 + m * 16 + fr; const f32x2v sr = S[r];
#pragma unroll
                for (int bj = 0; bj < 2; ++bj) {
                    const f32x4 o0 = (acc[ai][bj][m][0] - sr.x) * sr.y * g4[bj][0] + b4[bj][0], o1 = (acc[ai][bj][m][1] - sr.x) * sr.y * g4[bj][1] + b4[bj][1];
                    if (final_out) { float* yp = (outp + ((ai * 128 + m * 16) * DM + bj * 128)) + loff; *(f32x4*)yp = o0; *(f32x4*)(yp + 4) = o1; }
                    else { u32x4 w; w.x = cvt_pk_bf16(o0[0], o0[1]); w.y = cvt_pk_bf16(o0[2], o0[3]); w.z = cvt_pk_bf16(o1[0], o1[1]); w.w = cvt_pk_bf16(o1[2], o1[3]);
                        *(u32x4*)((outb + ((ai * 128 + m * 16) * DM + bj * 128)) + loff) = w; }
                }
                if (m & 1) asm volatile("" ::: "memory");
            }
    }
};

struct PhUp {
    Ctx c;
    DI bool get(int i, UnitD& u) const {
        const long L = (long)i * c.G + c.bid; if (L >= 132 * 22) return false;
        int pm, pn; g8::tile_of((int)L, 132, 22, pm, pn);
        u.A = (const char*)(XBp(c) + (size_t)pm * 256 * DM); u.B = (const char*)(wt_ptr(c, W_UP) + (size_t)pn * 256 * DM);
        u.lda = DM * 2; u.ldb = DM * 2; u.nt = DM / 64; u.pm = pm; u.pn = pn; u.sub = 0; u.split = 0; u.slot = 0; u.zero = true; u.perm = true; u.permA = true; return true;
    }
    DI void epi(Acc& acc, const UnitD& u, LAS unsigned char* lds, int tid, int wid, int lane, int wr, int wc, int fr, int fq) const {
        asm volatile("" : "+v"(fr), "+v"(fq), "+v"(tid));
        LAS float* HL = (LAS float*)(lds + HL_OFF);
        const bool samp = u.pm >= 128;
        const int tcol = wc * 32 + 8 * fq;
        const int ocol = u.pn * 128 + tcol;
        if (fr == 15) {
#pragma unroll
            for (int ai = 0; ai < 2; ++ai)
#pragma unroll
                for (int bj = 0; bj < 2; ++bj)
#pragma unroll
                    for (int n = 0; n < 2; ++n) {
                        *(LAS f32x4*)(HL + ((ai * 2 + wr) * 2 + 0) * 256 + bj * 128 + tcol + 4 * n) = acc[ai][bj][2][n];
                        *(LAS f32x4*)(HL + ((ai * 2 + wr) * 2 + 1) * 256 + bj * 128 + tcol + 4 * n) = acc[ai][bj][3][n];
                    }
        }
        asm volatile("s_waitcnt lgkmcnt(0)" ::: "memory"); __builtin_amdgcn_s_barrier(); asm volatile("" ::: "memory");
        const float* cw = c.a.in[22] + (size_t)c.layer * 3 * NUP; const float* cb = c.a.in[23] + (size_t)c.layer * NUP;
        float* halo = HALOp(c) + (size_t)u.pm * 4 * NUP;
        bf16_t* act = Hp(c) + (size_t)u.pm * 256 * DFF + u.pn * 128 + tcol;
        const bool even = (fr & 1) == 0;
        const f32x4 zero4 = {0.f, 0.f, 0.f, 0.f};
#pragma unroll
        for (int n = 0; n < 2; ++n) {
            f32x4 w0[2], w1[2], w2[2], bb[2];
#pragma unroll
            for (int bj = 0; bj < 2; ++bj) { const int oc = ocol + bj * DFF + 4 * n; w0[bj] = *(const f32x4*)(cw + oc); w1[bj] = *(const f32x4*)(cw + NUP + oc); w2[bj] = *(const f32x4*)(cw + 2 * NUP + oc); bb[bj] = *(const f32x4*)(cb + oc); }
#pragma unroll
            for (int ai = 0; ai < 2; ++ai) {
                const int row0 = ai * 128 + wr * 64 + 4 * fr;
                f32x4 cv[4][2];
#pragma unroll
                for (int bj = 0; bj < 2; ++bj) {
                    const int oc = ocol + bj * DFF + 4 * n;
                    f32x4 o3 = zero4, o2 = zero4;
                    f32x4 past0 = zero4, past1 = zero4;
                    if (!samp) {
                        const int sblk = ai * 2 + wr - 1;
                        if (sblk >= 0) { o2 = *(const LAS f32x4*)(HL + (sblk * 2 + 0) * 256 + bj * 128 + tcol + 4 * n); o3 = *(const LAS f32x4*)(HL + (sblk * 2 + 1) * 256 + bj * 128 + tcol + 4 * n); }
                    } else if (even) {
                        const int bglob = ((u.pm - 128) * 256 + row0) >> 3;
                        const float* st = c.a.in[5] + ((size_t)(c.layer * DB + bglob) * 2) * NUP + oc;
                        past0 = *(const f32x4*)st; past1 = *(const f32x4*)(st + NUP);
                    }
                    const f32x4 v0 = acc[ai][bj][0][n], v1 = acc[ai][bj][1][n], v2 = acc[ai][bj][2][n], v3 = acc[ai][bj][3][n];
                    f32x4 s3 = dppo4<0x111>(o3, v3), s2 = dppo4<0x111>(o2, v2);
                    f32x4 p1_0 = s3, p2_0 = s2, p2_1 = s3;
                    if (samp && even) { p1_0 = past1; p2_0 = past0; p2_1 = past1; }
                    cv[0][bj] = w0[bj] * p2_0 + w1[bj] * p1_0 + w2[bj] * v0 + bb[bj];
                    cv[1][bj] = w0[bj] * p2_1 + w1[bj] * v0 + w2[bj] * v1 + bb[bj];
                    cv[2][bj] = w0[bj] * v0 + w1[bj] * v1 + w2[bj] * v2 + bb[bj];
                    cv[3][bj] = w0[bj] * v1 + w1[bj] * v2 + w2[bj] * v3 + bb[bj];
                    if (!samp) {
                        if (ai == 0 && wr == 0 && fr == 0) { *(f32x4*)(halo + oc) = v0; *(f32x4*)(halo + (size_t)NUP + oc) = v1; }
                        if (ai == 1 && wr == 1 && fr == 15) {
                            *(f32x4*)(halo + (size_t)2 * NUP + oc) = v2; *(f32x4*)(halo + (size_t)3 * NUP + oc) = v3;
                            if ((u.pm & 7) == 7) { float* fo = c.out + O_FCP + ((size_t)(c.layer * NB + (u.pm >> 3)) * 2) * NUP + oc; *(f32x4*)fo = v2; *(f32x4*)(fo + NUP) = v3; }
                        }
                    } else if (!even) {
                        const int bglob = ((u.pm - 128) * 256 + row0) >> 3;
                        float* fo = c.out + O_FCS + ((size_t)(c.layer * DB + bglob) * 2) * NUP + oc; *(f32x4*)fo = v2; *(f32x4*)(fo + NUP) = v3;
                    }
                }
#pragma unroll
                for (int m = 0; m < 4; ++m) {
                    f32x4 o;
#pragma unroll
                    for (int e = 0; e < 4; ++e) { const float g = cv[m][1][e]; o[e] = cv[m][0][e] * g * __builtin_amdgcn_rcpf(1.f + fast_exp(-g)); }
                    u32x2 w; w.x = cvt_pk_bf16(o[0], o[1]); w.y = cvt_pk_bf16(o[2], o[3]);
                    *(u32x2*)(act + (size_t)(row0 + m) * DFF + 4 * n) = w;
                }
            }
        }
    }
};

DI void transpose_item(const float* W, int K, int N, bf16_t* WT, int mode, LAS float* scr, int item, int lane) {
    const int nblk = N / 32, kb = item / nblk, nb = item % nblk, k0 = 64 * kb, n0 = 32 * nb;
    float wv[32];
#pragma unroll
    for (int i = 0; i < 32; ++i) wv[i] = W[(size_t)(k0 + 2 * i + (lane >> 5)) * N + n0 + (lane & 31)];
#pragma unroll
    for (int i = 0; i < 32; ++i) scr[(2 * i + (lane >> 5)) * 33 + (lane & 31)] = wv[i];
    asm volatile("s_waitcnt lgkmcnt(0)" ::: "memory");
    int r0 = n0;
    if (mode == 1) { const int half = n0 / DFF, cc = n0 - half * DFF; r0 = (cc / 128) * 256 + half * 128 + (cc & 127); }
    const int cch = lane & 7;
#pragma unroll
    for (int j = 0; j < 4; ++j) { const int n = (lane >> 3) + 8 * j; const LAS float* s = scr + (8 * cch) * 33 + n;
        u32x4 o; o.x = cvt_pk_bf16(s[0 * 33], s[1 * 33]); o.y = cvt_pk_bf16(s[2 * 33], s[3 * 33]); o.z = cvt_pk_bf16(s[4 * 33], s[5 * 33]); o.w = cvt_pk_bf16(s[6 * 33], s[7 * 33]);
        *(u32x4*)(WT + (size_t)(r0 + n) * K + k0 + 8 * cch) = o; }
    asm volatile("s_waitcnt lgkmcnt(0)" ::: "memory");
}
constexpr int CW_IN = 16 * (NIN / 32), CW_G = 16 * (NGATE / 32), CW_P = 8 * 32, CW_O = 16 * 32, CW_UP = 16 * (NUP / 32), CW_DN = (DFF / 64) * 32;
constexpr int CW_A = CW_IN + CW_G + 3 * CW_P  , CW_B = CW_A + CW_O + CW_UP  , CW_ALL = CW_B + CW_DN;
DI void convert_layer_weights(const Ctx& c, int l, LAS float* scr, int gw, int NGW, int lane, int it_lo = 0, int it_hi = 1 << 30) {
    constexpr int I_IN = 16 * (NIN / 32), I_G = 16 * (NGATE / 32), I_P = 8 * 32, I_O = 16 * 32, I_UP = 16 * (NUP / 32), I_DN = (DFF / 64) * 32;
    constexpr int I_LAYER = I_IN + I_G + 3 * I_P + I_O + I_UP + I_DN;
    bf16_t* wt = (bf16_t*)(c.ws + WS_WT) + (size_t)l * W_LAYER;
    const int hi_ = it_hi < I_LAYER ? it_hi : I_LAYER;
    for (int it = it_lo + gw; it < hi_; it += NGW) {
        int r = it;
        if (r < I_IN) { transpose_item(c.a.in[6] + (size_t)l * DM * NIN, DM, NIN, wt + W_IN, 0, scr, r, lane); continue; } r -= I_IN;
        if (r < I_G) { transpose_item(c.a.in[7] + (size_t)l * DM * NGATE, DM, NGATE, wt + W_G, 0, scr, r, lane); continue; } r -= I_G;
        if (r < I_P) { transpose_item(c.a.in[15] + (size_t)l * 512 * 1024, 512, 1024, wt + W_PA, 0, scr, r, lane); continue; } r -= I_P;
        if (r < I_P) { transpose_item(c.a.in[16] + (size_t)l * 512 * 1024, 512, 1024, wt + W_PG, 0, scr, r, lane); continue; } r -= I_P;
        if (r < I_P) { transpose_item(c.a.in[17] + (size_t)l * 512 * 1024, 512, 1024, wt + W_PC, 0, scr, r, lane); continue; } r -= I_P;
        if (r < I_O) { transpose_item(c.a.in[18] + (size_t)l * 1024 * 1024, 1024, 1024, wt + W_O, 0, scr, r, lane); continue; } r -= I_O;
        if (r < I_UP) { transpose_item(c.a.in[21] + (size_t)l * DM * NUP, DM, NUP, wt + W_UP, 1, scr, r, lane); continue; } r -= I_UP;
        transpose_item(c.a.in[24] + (size_t)l * DFF * DM, DFF, DM, wt + W_DN, 0, scr, r, lane);
    }
}
DI void phase_prologue(const Ctx& c, LAS unsigned char* lds, int tid) {
    const int wave = tid >> 6, lane = tid & 63;
    LAS float* scr = (LAS float*)(lds + wave * 16384);
    const int gw = c.bid * 8 + wave, NGW = c.G * 8;
    convert_layer_weights(c, 0, scr, gw, NGW, lane, 0, CW_A);
    for (int m0 = gw * 4; m0 < MT; m0 += NGW * 4) {
        const float* src = m0 < MP ? c.a.in[0] + (size_t)m0 * DM : c.a.in[1] + (size_t)(m0 - MP) * DM;
        bf16_t* dst = XBp(c) + (size_t)m0 * DM;
        f32x4 v[4][4];
#pragma unroll
        for (int r = 0; r < 4; ++r)
#pragma unroll
            for (int j = 0; j < 4; ++j) v[r][j] = *(const f32x4*)(src + (size_t)r * DM + 4 * lane + 256 * j);
#pragma unroll
        for (int r = 0; r < 4; ++r)
#pragma unroll
            for (int j = 0; j < 4; ++j) { u32x2 w; w.x = cvt_pk_bf16(v[r][j].x, v[r][j].y); w.y = cvt_pk_bf16(v[r][j].z, v[r][j].w); *(u32x2*)(dst + (size_t)r * DM + 4 * lane + 256 * j) = w; }
    }
}

DI void phase_ln(const Ctx& c, const float* g, const float* b, int tid) {
    const int wave = tid >> 6, lane = tid & 63;
    const int gw = c.bid * 8 + wave, NGW = c.G * 8;
    f32x4 gv[4], bv[4];
#pragma unroll
    for (int j = 0; j < 4; ++j) { gv[j] = *(const f32x4*)(g + 4 * lane + 256 * j); bv[j] = *(const f32x4*)(b + 4 * lane + 256 * j); }
    for (int m = gw; m < MT; m += NGW) {
        float* xr = XFp(c) + (size_t)m * DM; bf16_t* xb = XBp(c) + (size_t)m * DM;
        f32x4 v[4]; float s = 0.f;
#pragma unroll
        for (int j = 0; j < 4; ++j) { v[j] = *(const f32x4*)(xr + 4 * lane + 256 * j); s += (v[j].x + v[j].y) + (v[j].z + v[j].w); }
        const float mean = wave_sum(s) * (1.f / DM); float s2 = 0.f;
#pragma unroll
        for (int j = 0; j < 4; ++j) { v[j] = v[j] - mean; s2 += (v[j].x * v[j].x + v[j].y * v[j].y) + (v[j].z * v[j].z + v[j].w * v[j].w); }
        const float rstd = 1.f / sqrtf(wave_sum(s2) * (1.f / DM) + LN_EPS);
#pragma unroll
        for (int j = 0; j < 4; ++j) { const f32x4 o = v[j] * rstd * gv[j] + bv[j]; *(f32x4*)(xr + 4 * lane + 256 * j) = o;
            u32x2 w; w.x = cvt_pk_bf16(o.x, o.y); w.y = cvt_pk_bf16(o.z, o.w); *(u32x2*)(xb + 4 * lane + 256 * j) = w; }
    }
}

DI void phase_fixup(const Ctx& c, int tid) {
    const float* cw = c.a.in[22] + (size_t)c.layer * 3 * NUP; const float* cb = c.a.in[23] + (size_t)c.layer * NUP;
    const float* halo = HALOp(c);
    bf16_t* act = Hp(c);
    for (int it = c.bid * 512 + tid; it < 128 * DFF; it += c.G * 512) {
        const int pm = it / DFF, col = it - pm * DFF;
        const float* h = halo + (size_t)pm * 4 * NUP;
        float cv[2][2];
#pragma unroll
        for (int bj = 0; bj < 2; ++bj) {
            const int oc = col + bj * DFF;
            const float v0 = h[oc], v1 = h[NUP + oc];
            float q2 = 0.f, q3 = 0.f;
            if ((pm & 7) != 0) { q2 = h[oc - 2 * (long)NUP]; q3 = h[oc - (long)NUP]; }
            const float w0 = cw[oc], w1 = cw[NUP + oc], w2 = cw[2 * NUP + oc], bb = cb[oc];
            cv[0][bj] = w0 * q2 + w1 * q3 + w2 * v0 + bb;
            cv[1][bj] = w0 * q3 + w1 * v0 + w2 * v1 + bb;
        }
#pragma unroll
        for (int r = 0; r < 2; ++r) { const float gg = cv[r][1]; act[(size_t)(pm * 256 + r) * DFF + col] = f2bf(cv[r][0] * gg * __builtin_amdgcn_rcpf(1.f + fast_exp(-gg))); }
    }
}

#define MFMA32(a, b, c) __builtin_amdgcn_mfma_f32_32x32x16_bf16((a), (b), (c), 0, 0, 0)
DI int crow(int r, int h) { return (r & 3) + 8 * (r >> 2) + 4 * h; }

DI void attn_prompt_item(const Ctx& c, LAS unsigned char* lds, int item, int tid) {
    asm volatile("" : "+v"(tid));
    const int hp = item & 1, kvh = (item >> 1) & 1, n = (item >> 2) & 15, b = item >> 6;
    const int wave = tid >> 6, lane = tid & 63, l31 = lane & 31, lh = lane >> 5;
    bf16_t* H = Hp(c);
    LAS bf16_t* Ks = (LAS bf16_t*)lds;
    LAS bf16_t* Vt = (LAS bf16_t*)(lds + 256 * 144);
    LAS bf16_t* Pb = (LAS bf16_t*)(lds + 256 * 144 + 64 * 528 + wave * 2560);
    const size_t row0 = (size_t)b * SEQ + (size_t)n * 128;
#pragma unroll
    for (int q = 0; q < 4; ++q) {
        const int ch = tid + 512 * q, kr = ch >> 3, part = ch & 7;
        u32x4 kv = (u32x4){0u, 0u, 0u, 0u}, vv = kv;
        if (n > 0 || kr >= 128) {
            const bf16_t* src = H + (row0 - 128 + kr) * LDH + kvh * 64 + part * 8;
            kv = *(const u32x4*)(src + KO); vv = *(const u32x4*)(src + VO);
        }
        *(LAS u32x4*)(Ks + kr * 72 + part * 8) = kv;
        const int d0 = part * 8;
        Vt[(d0 + 0) * 264 + kr] = (bf16_t)(vv.x & 0xffff); Vt[(d0 + 1) * 264 + kr] = (bf16_t)(vv.x >> 16);
        Vt[(d0 + 2) * 264 + kr] = (bf16_t)(vv.y & 0xffff); Vt[(d0 + 3) * 264 + kr] = (bf16_t)(vv.y >> 16);
        Vt[(d0 + 4) * 264 + kr] = (bf16_t)(vv.z & 0xffff); Vt[(d0 + 5) * 264 + kr] = (bf16_t)(vv.z >> 16);
        Vt[(d0 + 6) * 264 + kr] = (bf16_t)(vv.w & 0xffff); Vt[(d0 + 7) * 264 + kr] = (bf16_t)(vv.w >> 16);
    }
    __syncthreads();
    const int h = kvh * 4 + hp * 2 + (wave >> 2), a = wave & 3;
    const float slope = exp2f(-(float)(h + 1));
    const float sink = c.a.in[14][c.layer * 8 + h];
    bf16x8 qf[4];
    {
        const bf16_t* qp = H + (row0 + 32 * a + l31) * LDH + QO + h * 64 + 8 * lh;
#pragma unroll
        for (int ks = 0; ks < 4; ++ks) qf[ks] = *(const bf16x8*)(qp + 16 * ks);
    }
    f32x16 S[5];
#pragma unroll
    for (int kb = 0; kb < 5; ++kb) {
        f32x16 s;
#pragma unroll
        for (int r = 0; r < 16; ++r) s[r] = 0.f;
        const int j0 = 32 * a + 32 * kb;
#pragma unroll
        for (int ks = 0; ks < 4; ++ks) {
            const bf16x8 kf = *(const LAS bf16x8*)(Ks + (j0 + l31) * 72 + 16 * ks + 8 * lh);
            s = MFMA32(qf[ks], kf, s);
        }
        const int j = j0 + l31;
#pragma unroll
        for (int r = 0; r < 16; ++r) {
            const int i = 32 * a + crow(r, lh); const int dist = i + 128 - j;
            const bool ok = (dist >= 0) && (dist <= 128) && (n > 0 || j >= 128);
            s[r] = ok ? s[r] * 0.125f - slope * (float)dist : -1e30f;
        }
        S[kb] = s;
        asm volatile("" ::: "memory");
    }
    float drow[16];
#pragma unroll
    for (int r = 0; r < 16; ++r) {
        float mx = fmaxf(fmaxf(fmaxf(S[0][r], S[1][r]), fmaxf(S[2][r], S[3][r])), S[4][r]);
#pragma unroll
        for (int o = 1; o < 32; o <<= 1) mx = fmaxf(mx, __shfl_xor(mx, o));
        mx = fmaxf(mx, sink);
        float sm = 0.f;
#pragma unroll
        for (int kb = 0; kb < 5; ++kb) { const float p = fast_exp(S[kb][r] - mx); S[kb][r] = p; sm += p; }
#pragma unroll
        for (int o = 1; o < 32; o <<= 1) sm += __shfl_xor(sm, o);
        drow[r] = __builtin_amdgcn_rcpf(sm + fast_exp(sink - mx));
    }
    f32x16 O0, O1;
#pragma unroll
    for (int r = 0; r < 16; ++r) { O0[r] = 0.f; O1[r] = 0.f; }
#pragma unroll
    for (int kb = 0; kb < 5; ++kb) {
        const int j0 = 32 * a + 32 * kb;
#pragma unroll
        for (int r = 0; r < 16; ++r) Pb[crow(r, lh) * 40 + l31] = f2bf(S[kb][r]);
        asm volatile("s_waitcnt lgkmcnt(0)" ::: "memory");
#pragma unroll
        for (int k2 = 0; k2 < 2; ++k2) {
            const bf16x8 pf = *(const LAS bf16x8*)(Pb + l31 * 40 + 16 * k2 + 8 * lh);
            const bf16x8 v0 = *(const LAS bf16x8*)(Vt + l31 * 264 + j0 + 16 * k2 + 8 * lh);
            const bf16x8 v1 = *(const LAS bf16x8*)(Vt + (32 + l31) * 264 + j0 + 16 * k2 + 8 * lh);
            O0 = MFMA32(pf, v0, O0); O1 = MFMA32(pf, v1, O1);
        }
        asm volatile("s_waitcnt lgkmcnt(0)" ::: "memory");
    }
    {
        bf16_t* op = H + (row0 + 32 * a) * LDH + QO + h * 64 + l31;
#pragma unroll
        for (int r = 0; r < 16; ++r) { bf16_t* p = op + (size_t)crow(r, lh) * LDH; p[0] = f2bf(O0[r] * drow[r]); p[32] = f2bf(O1[r] * drow[r]); }
    }
    __syncthreads();
}

DI void attn_sample_item(const Ctx& c, LAS unsigned char* wl  , int item, int lane) {
    asm volatile("" : "+v"(lane));
    const int h = item & 7, b = item >> 3, kvh = h >> 2;
    bf16_t* H = Hp(c);
    LAS float* qs = (LAS float*)wl;
    LAS float* ps = (LAS float*)(wl + 2048);
    const size_t r0 = (size_t)MP + (size_t)b * 8;
    const float slope = exp2f(-(float)(h + 1));
    const float sink = c.a.in[14][c.layer * 8 + h];
#pragma unroll
    for (int i = 0; i < 8; ++i) qs[lane * 8 + i] = bf2f(H[(r0 + i) * LDH + QO + h * 64 + lane]);
    asm volatile("s_waitcnt lgkmcnt(0)" ::: "memory");
    const float* ck = c.a.in[2] + ((size_t)(c.layer * DB + b) * 128) * 128 + kvh * 64;
    const float* cv = c.a.in[3] + ((size_t)(c.layer * DB + b) * 128) * 128 + kvh * 64;
    float sc[3][8];
#pragma unroll
    for (int p = 0; p < 3; ++p) {
        const int j = lane + 64 * p;
        f32x4 kf[16];
        if (p < 2) {
            const float* kr = ck + (size_t)j * 128;
#pragma unroll
            for (int q4 = 0; q4 < 16; ++q4) kf[q4] = *(const f32x4*)(kr + 4 * q4);
        } else {
            const int jj = (j < 136) ? j - 128 : 0;
            const bf16_t* kr = H + (r0 + jj) * LDH + KO + kvh * 64;
#pragma unroll
            for (int q8 = 0; q8 < 8; ++q8) { const u32x4 w = *(const u32x4*)(kr + 8 * q8);
                kf[2 * q8] = (f32x4){bf_lo(w.x), bf_hi(w.x), bf_lo(w.y), bf_hi(w.y)}; kf[2 * q8 + 1] = (f32x4){bf_lo(w.z), bf_hi(w.z), bf_lo(w.w), bf_hi(w.w)}; }
        }
        float a8[8];
#pragma unroll
        for (int i = 0; i < 8; ++i) a8[i] = 0.f;
#pragma unroll
        for (int q4 = 0; q4 < 16; ++q4)
#pragma unroll
            for (int e = 0; e < 4; ++e) { const int d = 4 * q4 + e; const float kv = kf[q4][e];
                const f32x4 q0 = *(const LAS f32x4*)(qs + d * 8), q1 = *(const LAS f32x4*)(qs + d * 8 + 4);
                a8[0] += kv * q0[0]; a8[1] += kv * q0[1]; a8[2] += kv * q0[2]; a8[3] += kv * q0[3]; a8[4] += kv * q1[0]; a8[5] += kv * q1[1]; a8[6] += kv * q1[2]; a8[7] += kv * q1[3]; }
#pragma unroll
        for (int i = 0; i < 8; ++i) { const int dist = i + 128 - j; const bool ok = (j < 136) && dist >= 0 && dist <= 128; sc[p][i] = ok ? a8[i] * 0.125f - slope * (float)dist : -1e30f; }
        asm volatile("" ::: "memory");
    }
    float inv[8];
#pragma unroll
    for (int i = 0; i < 8; ++i) {
        const float mx = fmaxf(wave_max(fmaxf(fmaxf(sc[0][i], sc[1][i]), sc[2][i])), sink);
        float sm = 0.f;
#pragma unroll
        for (int p = 0; p < 3; ++p) { sc[p][i] = fast_exp(sc[p][i] - mx); sm += sc[p][i]; }
        inv[i] = 1.f / (wave_sum(sm) + fast_exp(sink - mx));
    }
#pragma unroll
    for (int p = 0; p < 3; ++p) { const int j = lane + 64 * p; if (j < 136) {
#pragma unroll
        for (int i = 0; i < 8; ++i) ps[j * 8 + i] = sc[p][i] * inv[i]; } }
    asm volatile("s_waitcnt lgkmcnt(0)" ::: "memory");
    float o[8];
#pragma unroll
    for (int i = 0; i < 8; ++i) o[i] = 0.f;
#pragma unroll 1
    for (int jb = 0; jb < 4; ++jb) {
        float vv[34];
#pragma unroll
        for (int u = 0; u < 34; ++u) { const int j = jb * 34 + u; vv[u] = j < 128 ? cv[(size_t)j * 128 + lane] : bf2f(H[(r0 + (j - 128)) * LDH + VO + kvh * 64 + lane]); }
#pragma unroll
        for (int u = 0; u < 34; ++u) { const int j = jb * 34 + u;
            const f32x4 p0 = *(const LAS f32x4*)(ps + j * 8), p1 = *(const LAS f32x4*)(ps + j * 8 + 4);
            o[0] += vv[u] * p0[0]; o[1] += vv[u] * p0[1]; o[2] += vv[u] * p0[2]; o[3] += vv[u] * p0[3]; o[4] += vv[u] * p1[0]; o[5] += vv[u] * p1[1]; o[6] += vv[u] * p1[2]; o[7] += vv[u] * p1[3]; }
    }
#pragma unroll
    for (int i = 0; i < 8; ++i) H[(r0 + i) * LDH + QO + h * 64 + lane] = f2bf(o[i]);
    asm volatile("s_waitcnt lgkmcnt(0)" ::: "memory");
}

DI void gmlp_prompt_item(const Ctx& c, LAS unsigned char* lds, int item, int tid) {
    asm volatile("" : "+v"(tid));
    const int wave = tid >> 6, lane = tid & 63, l31 = lane & 31, lh = lane >> 5;
    bf16_t* H = Hp(c);
    LAS bf16_t* VnT = (LAS bf16_t*)lds;
    const size_t row0 = (size_t)item * 128;
    const float* lg = c.a.in[9] + c.layer * 512; const float* lb = c.a.in[10] + c.layer * 512;
    float g8v[8], b8v[8];
#pragma unroll
    for (int e = 0; e < 8; ++e) { g8v[e] = lg[lane + 64 * e]; b8v[e] = lb[lane + 64 * e]; }
    bf16_t raw[16][8];
#pragma unroll
    for (int rr = 0; rr < 16; ++rr) { const bf16_t* src = H + (row0 + wave * 16 + rr) * LDH + GVO;
#pragma unroll
        for (int e = 0; e < 8; ++e) raw[rr][e] = src[lane + 64 * e]; }
#pragma unroll
    for (int rr = 0; rr < 16; ++rr) {
        const int s = wave * 16 + rr;
        float v[8]; float sm = 0.f;
#pragma unroll
        for (int e = 0; e < 8; ++e) { v[e] = bf2f(raw[rr][e]); sm += v[e]; }
        const float mean = wave_sum(sm) * (1.f / 512.f); float s2 = 0.f;
#pragma unroll
        for (int e = 0; e < 8; ++e) { v[e] -= mean; s2 += v[e] * v[e]; }
        const float rstd = 1.f / sqrtf(wave_sum(s2) * (1.f / 512.f) + LN_EPS);
#pragma unroll
        for (int e = 0; e < 8; ++e) VnT[(lane + 64 * e) * 136 + s] = f2bf(v[e] * rstd * g8v[e] + b8v[e]);
    }
    __syncthreads();
    const int g = wave >> 1, ch = wave & 1;
    const float* Ws = c.a.in[11] + ((size_t)(c.layer * 4 + g) * 128) * 128;
    f32x16 acc[4][2];
#pragma unroll
    for (int tb = 0; tb < 4; ++tb)
#pragma unroll
        for (int cb = 0; cb < 2; ++cb)
#pragma unroll
            for (int r = 0; r < 16; ++r) acc[tb][cb][r] = 0.f;
#pragma unroll
    for (int ks = 0; ks < 8; ++ks) {
        bf16x8 bfr[2];
#pragma unroll
        for (int cb = 0; cb < 2; ++cb) bfr[cb] = *(const LAS bf16x8*)(VnT + (g * 128 + ch * 64 + 32 * cb + l31) * 136 + 16 * ks + 8 * lh);
#pragma unroll
        for (int tb = 0; tb < 4; ++tb) {
            if (ks <= 2 * tb + 1) {
                const int t = 32 * tb + l31, s0 = 16 * ks + 8 * lh;
                const f32x4 w0 = *(const f32x4*)(Ws + (size_t)t * 128 + s0), w1 = *(const f32x4*)(Ws + (size_t)t * 128 + s0 + 4);
                u32x4 pk;
                pk.x = cvt_pk_bf16(s0 + 0 <= t ? w0[0] : 0.f, s0 + 1 <= t ? w0[1] : 0.f); pk.y = cvt_pk_bf16(s0 + 2 <= t ? w0[2] : 0.f, s0 + 3 <= t ? w0[3] : 0.f);
                pk.z = cvt_pk_bf16(s0 + 4 <= t ? w1[0] : 0.f, s0 + 5 <= t ? w1[1] : 0.f); pk.w = cvt_pk_bf16(s0 + 6 <= t ? w1[2] : 0.f, s0 + 7 <= t ? w1[3] : 0.f);
                const bf16x8 af = __builtin_bit_cast(bf16x8, pk);
#pragma unroll
                for (int cb = 0; cb < 2; ++cb) acc[tb][cb] = MFMA32(af, bfr[cb], acc[tb][cb]);
            }
        }
    }
    const float* bs = c.a.in[12] + (size_t)(c.layer * 4 + g) * 128;
#pragma unroll
    for (int tb = 0; tb < 4; ++tb)
#pragma unroll
        for (int r = 0; r < 16; ++r) {
            const int t = 32 * tb + crow(r, lh); const float bt = bs[t];
            bf16_t* gp = H + (row0 + t) * LDH + GUO + g * 128 + ch * 64 + l31;
#pragma unroll
            for (int cb = 0; cb < 2; ++cb) gp[32 * cb] = f2bf(bf2f(gp[32 * cb]) * (acc[tb][cb][r] + bt));
        }
    __syncthreads();
}

DI void gmlp_sample_item(const Ctx& c, int b, int lane) {
    asm volatile("" : "+v"(lane));
    bf16_t* H = Hp(c);
    const size_t r0 = (size_t)MP + (size_t)b * 8;
    const float* lg = c.a.in[9] + c.layer * 512; const float* lb = c.a.in[10] + c.layer * 512;
    float vn[8][8];
#pragma unroll
    for (int s = 0; s < 8; ++s) {
        const bf16_t* src = H + (r0 + s) * LDH + GVO;
        float sm = 0.f;
#pragma unroll
        for (int e = 0; e < 8; ++e) { vn[s][e] = bf2f(src[lane + 64 * e]); sm += vn[s][e]; }
        const float mean = wave_sum(sm) * (1.f / 512.f); float s2 = 0.f;
#pragma unroll
        for (int e = 0; e < 8; ++e) { vn[s][e] -= mean; s2 += vn[s][e] * vn[s][e]; }
        const float rstd = 1.f / sqrtf(wave_sum(s2) * (1.f / 512.f) + LN_EPS);
        float* go = c.out + O_GVS + ((size_t)(c.layer * DB + b) * 8 + s) * 512;
#pragma unroll
        for (int e = 0; e < 8; ++e) { vn[s][e] = vn[s][e] * rstd * lg[lane + 64 * e] + lb[lane + 64 * e]; go[lane + 64 * e] = vn[s][e]; }
    }
#pragma unroll
    for (int t = 0; t < 8; ++t) {
        bf16_t* gp = H + (r0 + t) * LDH + GUO;
#pragma unroll
        for (int e = 0; e < 8; ++e) {
            const int g = e >> 1;
            const float* Ws = c.a.in[11] + ((size_t)(c.layer * 4 + g) * 128 + t) * 128;
            float a = c.a.in[12][(c.layer * 4 + g) * 128 + t];
#pragma unroll
            for (int s = 0; s < 8; ++s) if (s <= t) a += Ws[s] * vn[s][e];
            gp[lane + 64 * e] = f2bf(bf2f(gp[lane + 64 * e]) * a);
        }
    }
}

DI void phase_mixer(const Ctx& c, LAS unsigned char* lds, int tid) {
    const int wave = tid >> 6, lane = tid & 63;
    for (int it = c.bid; it < 1024; it += c.G) attn_prompt_item(c, lds, it, tid);
    for (int it = c.bid; it < 256; it += c.G) gmlp_prompt_item(c, lds, it, tid);
    __syncthreads();
    for (int it = c.bid * 8 + wave; it < 1024 + 128; it += c.G * 8) {
        if (it < 1024) attn_sample_item(c, lds + wave * 8192, it, lane);
        else gmlp_sample_item(c, it - 1024, lane);
    }
    bf16_t* H = Hp(c);
    const int gt = c.bid * 512 + tid, GT = c.G * 512;
    {
        const int c0 = (gt & 63) * 8;
        const float* mw = c.a.in[13] + (size_t)c.layer * 3 * 512 + c0;
        float w0[8], w1[8], w2[8];
#pragma unroll
        for (int e = 0; e < 8; ++e) { w0[e] = mw[e]; w1[e] = mw[512 + e]; w2[e] = mw[1024 + e]; }
#pragma unroll 1
        for (int run = gt >> 6; run < MT / 8; run += GT >> 6) {
            const int row0 = run * 8; const bool samp = row0 >= MP;
            int t0, b; if (!samp) { t0 = row0 & (SEQ - 1); b = row0 >> 11; } else { t0 = 0; b = (row0 - MP) >> 3; }
            float z0[8], z1[8];
            if (samp) { const float* st = c.a.in[4] + ((size_t)(c.layer * DB + b) * 2) * 512 + c0;
#pragma unroll
                for (int e = 0; e < 8; ++e) { z0[e] = st[e]; z1[e] = st[512 + e]; } }
            else if (t0 == 0) {
#pragma unroll
                for (int e = 0; e < 8; ++e) { z0[e] = 0.f; z1[e] = 0.f; } }
            else { const bf16_t* hp = H + (size_t)(row0 - 2) * LDH;
                const u32x4 a0 = *(const u32x4*)(hp + SCO + c0), d0 = *(const u32x4*)(hp + SHO + c0), a1 = *(const u32x4*)(hp + LDH + SCO + c0), d1 = *(const u32x4*)(hp + LDH + SHO + c0);
                z0[0] = bf_lo(a0.x) * bf_lo(d0.x); z0[1] = bf_hi(a0.x) * bf_hi(d0.x); z0[2] = bf_lo(a0.y) * bf_lo(d0.y); z0[3] = bf_hi(a0.y) * bf_hi(d0.y);
                z0[4] = bf_lo(a0.z) * bf_lo(d0.z); z0[5] = bf_hi(a0.z) * bf_hi(d0.z); z0[6] = bf_lo(a0.w) * bf_lo(d0.w); z0[7] = bf_hi(a0.w) * bf_hi(d0.w);
                z1[0] = bf_lo(a1.x) * bf_lo(d1.x); z1[1] = bf_hi(a1.x) * bf_hi(d1.x); z1[2] = bf_lo(a1.y) * bf_lo(d1.y); z1[3] = bf_hi(a1.y) * bf_hi(d1.y);
                z1[4] = bf_lo(a1.z) * bf_lo(d1.z); z1[5] = bf_hi(a1.z) * bf_hi(d1.z); z1[6] = bf_lo(a1.w) * bf_lo(d1.w); z1[7] = bf_hi(a1.w) * bf_hi(d1.w); }
            u32x4 av[8], dv[8], sv[8];
#pragma unroll
            for (int r = 0; r < 8; ++r) { const bf16_t* hr = H + (size_t)(row0 + r) * LDH; av[r] = *(const u32x4*)(hr + SCO + c0); dv[r] = *(const u32x4*)(hr + SHO + c0); sv[r] = *(const u32x4*)(hr + SBO + c0); }
#pragma unroll
            for (int r = 0; r < 8; ++r) {
                float z2[8];
                z2[0] = bf_lo(av[r].x) * bf_lo(dv[r].x); z2[1] = bf_hi(av[r].x) * bf_hi(dv[r].x); z2[2] = bf_lo(av[r].y) * bf_lo(dv[r].y); z2[3] = bf_hi(av[r].y) * bf_hi(dv[r].y);
                z2[4] = bf_lo(av[r].z) * bf_lo(dv[r].z); z2[5] = bf_hi(av[r].z) * bf_hi(dv[r].z); z2[6] = bf_lo(av[r].w) * bf_lo(dv[r].w); z2[7] = bf_hi(av[r].w) * bf_hi(dv[r].w);
                const float sbf[8] = {bf_lo(sv[r].x), bf_hi(sv[r].x), bf_lo(sv[r].y), bf_hi(sv[r].y), bf_lo(sv[r].z), bf_hi(sv[r].z), bf_lo(sv[r].w), bf_hi(sv[r].w)};
                float o[8];
#pragma unroll
                for (int e = 0; e < 8; ++e) o[e] = sbf[e] * (w0[e] * z0[e] + w1[e] * z1[e] + w2[e] * z2[e]);
                u32x4 w; w.x = cvt_pk_bf16(o[0], o[1]); w.y = cvt_pk_bf16(o[2], o[3]); w.z = cvt_pk_bf16(o[4], o[5]); w.w = cvt_pk_bf16(o[6], o[7]);
                *(u32x4*)(H + (size_t)(row0 + r) * LDH + SBO + c0) = w;
                const int t = t0 + r; const int tl = samp ? DS : SEQ;
                if (t >= tl - 2) {
                    float* dst = c.out + (samp ? O_MCS + ((size_t)(c.layer * DB + b) * 2 + (t - (tl - 2))) * 512 : O_MCP + ((size_t)(c.layer * NB + b) * 2 + (t - (tl - 2))) * 512) + c0;
                    *(f32x4*)dst = (f32x4){z2[0], z2[1], z2[2], z2[3]}; *(f32x4*)(dst + 4) = (f32x4){z2[4], z2[5], z2[6], z2[7]};
                }
#pragma unroll
                for (int e = 0; e < 8; ++e) { z0[e] = z1[e]; z1[e] = z2[e]; }
            }
        }
    }
}

DI void phase_dbg(const Ctx& c, int tid) {
    const bf16_t* H = Hp(c);
#pragma unroll 1
    for (int it = c.bid * 512 + tid; it < MT * DM; it += c.G * 512) { const int row = it >> 10, col = it & 1023; c.out[it] = bf2f(H[(size_t)row * LDH + MGO + col]); }
}

DI void phase_windows(const Ctx& c, int gt, int GT) {
    bf16_t* H = Hp(c);
#pragma unroll 1
    for (int it = gt; it < NB * 128 * 32; it += GT) {
        const int cc = (it & 31) * 4, j = (it >> 5) & 127, b = it >> 12;
        const bf16_t* hr = H + ((size_t)b * SEQ + 1920 + j) * LDH;
        const u32x2 kq = *(const u32x2*)(hr + KO + cc), vq = *(const u32x2*)(hr + VO + cc);
        *(f32x4*)(c.out + O_KP + (size_t)c.layer * NB * 16384 + (size_t)it * 4) = (f32x4){bf_lo(kq.x), bf_hi(kq.x), bf_lo(kq.y), bf_hi(kq.y)};
        *(f32x4*)(c.out + O_VP + (size_t)c.layer * NB * 16384 + (size_t)it * 4) = (f32x4){bf_lo(vq.x), bf_hi(vq.x), bf_lo(vq.y), bf_hi(vq.y)};
    }
#pragma unroll 1
    for (int it = gt; it < DB * 128 * 32; it += GT) {
        const int cc = (it & 31) * 4, j = (it >> 5) & 127, b = it >> 12;
        f32x4 kv, vv;
        if (j < 120) { const size_t o = ((size_t)(c.layer * DB + b) * 128 + j + 8) * 128 + cc; kv = *(const f32x4*)(c.a.in[2] + o); vv = *(const f32x4*)(c.a.in[3] + o); }
        else { const bf16_t* hr = H + ((size_t)MP + b * 8 + (j - 120)) * LDH; const u32x2 kq = *(const u32x2*)(hr + KO + cc), vq = *(const u32x2*)(hr + VO + cc);
            kv = (f32x4){bf_lo(kq.x), bf_hi(kq.x), bf_lo(kq.y), bf_hi(kq.y)}; vv = (f32x4){bf_lo(vq.x), bf_hi(vq.x), bf_lo(vq.y), bf_hi(vq.y)}; }
        *(f32x4*)(c.out + O_KS + (size_t)c.layer * DB * 16384 + (size_t)it * 4) = kv;
        *(f32x4*)(c.out + O_VS + (size_t)c.layer * DB * 16384 + (size_t)it * 4) = vv;
    }
}
#define XB_TMO      128
#define XB_XCNT(j)  (256  + 64 * (j))
#define XB_XSUB(j)  (1280 + 64 * (j))
#define XB_XGEN(j)  (2304 + 64 * (j))
#define XB_TOP      3328
#define XB_TOPGEN   3392
#define XCD_BAR_WORDS 3456
#define XB_SPIN_CAP (1u << 18)
DI unsigned xb_ld(unsigned* p)              { return __hip_atomic_load(p, __ATOMIC_RELAXED, __HIP_MEMORY_SCOPE_AGENT); }
DI unsigned xb_add(unsigned* p, unsigned v) { return __hip_atomic_fetch_add(p, v, __ATOMIC_RELAXED, __HIP_MEMORY_SCOPE_AGENT); }
DI unsigned xb_xcc_id() { return (unsigned)__builtin_amdgcn_s_getreg((3 << 11) | 20) & 0xFu; }
#define XB_SPIN(cond, bar) do { unsigned _sp = 0; while (cond) { __builtin_amdgcn_s_sleep(1); \
    if ((++_sp & 255u) == 0u) { if (xb_ld(&(bar)[XB_TMO])) break; if (_sp > XB_SPIN_CAP) { atomicAdd(&(bar)[XB_TMO], 1u); break; } } } } while (0)
struct XcdBarrier { unsigned* bar; unsigned x; volatile LAS unsigned* st; };
DI XcdBarrier xcd_barrier_post(unsigned* bar, volatile LAS unsigned* st) {
    XcdBarrier b; b.bar = bar; b.x = xb_xcc_id(); b.st = st;
    if (threadIdx.x == 0) (void)xb_add(&bar[XB_XCNT(b.x)], 1u);
    return b;
}
DI void xcd_barrier_complete(unsigned* bar, unsigned x, unsigned& nloc, unsigned& nx) {
    const unsigned G = gridDim.x * gridDim.y * gridDim.z;
    unsigned sum, cnt, mine, sp = 0u;
    for (;;) {
        sum = 0u; cnt = 0u; mine = 0u;
#pragma unroll
        for (unsigned j = 0; j < 16; ++j) { const unsigned c = xb_ld(&bar[XB_XCNT(j)]); sum += c; cnt += (c > 0u) ? 1u : 0u; mine = (j == x) ? c : mine; }
        if (sum == G) break;
        __builtin_amdgcn_s_sleep(1);
        if ((++sp & 255u) == 0u) { if (xb_ld(&bar[XB_TMO])) break; if (sp > XB_SPIN_CAP) { atomicAdd(&bar[XB_TMO], 1u); break; } }
    }
    nloc = mine > 0u ? mine : 1u; nx = cnt > 0u ? cnt : 1u;
}
DI void xcd_barrier(const XcdBarrier& b, bool leader) {
    asm volatile("s_waitcnt vmcnt(0)" ::: "memory");
    __syncthreads();
    if (leader) {
        unsigned* bar = b.bar;
        __builtin_amdgcn_s_waitcnt(0);
        unsigned nloc = b.st[0], nx = b.st[1];
        if (nloc == 0u) { xcd_barrier_complete(bar, b.x, nloc, nx); b.st[0] = nloc; b.st[1] = nx; }
        const unsigned old = xb_add(&bar[XB_XSUB(b.x)], 1u);
        const unsigned gen = old / nloc;
        if (old + 1u == (gen + 1u) * nloc) {
            __builtin_amdgcn_fence(__ATOMIC_RELEASE, "agent");
            asm volatile("s_waitcnt vmcnt(0)" ::: "memory");
            const unsigned og = xb_add(&bar[XB_TOP], 1u);
            const unsigned tg = og / nx;
            if (og + 1u == (tg + 1u) * nx) xb_add(&bar[XB_TOPGEN], 1u);
            else XB_SPIN(xb_ld(&bar[XB_TOPGEN]) == tg, bar);
            __builtin_amdgcn_fence(__ATOMIC_ACQUIRE, "agent");
            xb_add(&bar[XB_XGEN(b.x)], 1u);
            asm volatile("s_waitcnt vmcnt(0)" ::: "memory");
        } else {
            XB_SPIN(xb_ld(&bar[XB_XGEN(b.x)]) == gen, bar);
            __builtin_amdgcn_fence(__ATOMIC_ACQUIRE, "agent");
            asm volatile("s_waitcnt vmcnt(0)" ::: "memory");
        }
    }
    __syncthreads();
}
#ifndef REPMASK
#define REPMASK 0
#endif
DI int lane_id_fresh() { int l; asm volatile("v_mbcnt_lo_u32_b32 %0, -1, 0\n\tv_mbcnt_hi_u32_b32 %0, -1, %0" : "=v"(l)); return l; }
__global__ void __launch_bounds__(512, 2) fwd_kernel(Args args) {
    extern __shared__ __attribute__((aligned(16))) unsigned char smem[];
    LAS unsigned char* lds = (LAS unsigned char*)smem;
    cg::grid_group grid = cg::this_grid();
    int layer_s = 0;
    volatile LAS unsigned* xst = (volatile LAS unsigned*)(lds + LDS_BYTES - 64);
    if (threadIdx.x < 16) xst[threadIdx.x] = 0u;
    __syncthreads();
    const int wave_s = __builtin_amdgcn_readfirstlane((int)threadIdx.x >> 6);
    const XcdBarrier xbar = xcd_barrier_post((unsigned*)args.ws, xst);
#define SEAM_CG() do { asm volatile("s_waitcnt vmcnt(0) lgkmcnt(0)" ::: "memory");     \
        grid.sync(); \
        asm volatile("s_waitcnt vmcnt(0)" ::: "memory");                \
        __syncthreads(); } while (0)
#define SEAM() xcd_barrier(xbar, wave_s == 0 && lane_id_fresh() == 0)
#define RUN(...) { int tid = wave_s * 64 + lane_id_fresh(); \
        int g_ = (int)gridDim.x, b_ = (int)blockIdx.x, l_ = layer_s; unsigned char* w_ = args.ws; float* o_ = args.out; \
        asm volatile("" : "+s"(g_), "+s"(b_), "+s"(l_), "+s"(w_), "+s"(o_));     \
        const Ctx c{args, w_, o_, g_, b_, l_}; __VA_ARGS__; }
    RUN(phase_prologue(c, lds, tid)); SEAM_CG();
    for (int l = 0; l < 2; ++l) {
        layer_s = l;
        RUN({ PhIn p{c}; g8::run(lds, p, tid); }); SEAM();
        RUN(phase_mixer(c, lds, tid)); SEAM();
        RUN({ PhMerge p{c}; g8::run(lds, p, tid);
              { const int full = 528 / c.G, tail = 528 - full * c.G, busy = (2 * tail <= c.G && tail <= 16) ? 2 * tail : tail;
                if (c.bid >= busy) { phase_windows(c, (c.bid - busy) * 512 + tid, (c.G - busy) * 512);
                    if (l == 0) convert_layer_weights(c, 0, (LAS float*)(lds + (tid >> 6) * 16384), (c.bid - busy) * 8 + (tid >> 6), (c.G - busy) * 8, tid & 63, CW_A, CW_B); } } });
        SEAM();
        RUN({ PhRes p{c, 0}; g8::run(lds, p, tid);
              if (l == 0) { const int full = 528 / c.G, tail = 528 - full * c.G, busy = (2 * tail <= c.G && tail <= 16) ? 2 * tail : tail;
                  const int vcu = (c.G & 7) == 0 ? (c.bid & 7) * (c.G >> 3) + (c.bid >> 3) : c.bid;
                  if (vcu >= busy) convert_layer_weights(c, 0, (LAS float*)(lds + (tid >> 6) * 16384), (vcu - busy) * 8 + (tid >> 6), (c.G - busy) * 8, tid & 63, CW_B, CW_ALL); } }); SEAM();
        RUN({ PhUp p{c}; g8::run(lds, p, tid);
              if (l == 0) {
                  const int tiles = 132 * 22, tail = tiles % c.G, idle = tail ? c.G - tail : c.G, me = tail ? c.bid - tail : c.bid;
                  if (me >= 0) convert_layer_weights(c, 1, (LAS float*)(lds + (tid >> 6) * 16384), me * 8 + (tid >> 6), idle * 8, tid & 63);
              } }); SEAM();
        RUN(phase_fixup(c, tid)); SEAM();
        RUN({ PhRes p{c, 1}; g8::run(lds, p, tid); }); SEAM();
    }
}

extern "C" void kernel_launch(void* const* d_in, const int* in_sizes, int n_in, void* d_out, int out_size, void* d_ws, size_t ws_size, hipStream_t stream) {
    static int grid = 0;
    if (grid == 0) {
        int dev = 0, cus = 0, per_cu = 0;
        if (n_in != 27 || (size_t)out_size != O_END || ws_size < WS_END) { fprintf(stderr, "kernel_launch: unexpected shapes (n_in %d out %d ws %zu)\n", n_in, out_size, ws_size); grid = -1; return; }
        (void)hipGetDevice(&dev);
        (void)hipDeviceGetAttribute(&cus, hipDeviceAttributeMultiprocessorCount, dev);
        (void)hipFuncSetAttribute((const void*)fwd_kernel, hipFuncAttributeMaxDynamicSharedMemorySize, LDS_BYTES);
        (void)hipOccupancyMaxActiveBlocksPerMultiprocessor(&per_cu, (const void*)fwd_kernel, 512, LDS_BYTES);
        if (per_cu < 1) { fprintf(stderr, "kernel_launch: occupancy query says %d blocks per CU\n", per_cu); per_cu = 1; }
        grid = cus < 256 ? cus : 256;
    }
    if (grid < 0) return;
    if (hipMemsetAsync(d_ws, 0, CTL_ZERO_BYTES, stream) != hipSuccess) { fprintf(stderr, "kernel_launch: memset failed\n"); return; }
    Args a{};
    for (int i = 0; i < 27; ++i) a.in[i] = (const float*)d_in[i];
    a.out = (float*)d_out; a.ws = (unsigned char*)d_ws;
    void* kargs[] = {&a};
    hipError_t e = hipLaunchCooperativeKernel((const void*)fwd_kernel, dim3(grid), dim3(512), kargs, LDS_BYTES, stream);
    if (e != hipSuccess) fprintf(stderr, "cooperative launch failed: %s (grid %d)\n", hipGetErrorString(e), grid);
}
```
